# Optimizing an MI355X kernel written in HIP

```python
import math
import jax, jax.numpy as jnp
from jax import lax
import numpy as np

D_MODEL = 2048
BATCH = 4
SEQ = 4096
DEPTH = 2

D_BR = D_MODEL // 2
N_BRANCHES = 4
GMLP_CHUNK = 128
GMLP_GROUPS = 8
GMLP_GROUP_DIM = D_BR // GMLP_GROUPS
LRU_BLOCKS = 8
LRU_BLOCK_DIM = D_BR // LRU_BLOCKS
CONV_WIDTH = 4
LRU_C = 8.0
NSA_HEAD_DIM = 64
NSA_HEADS = D_BR // NSA_HEAD_DIM
NSA_KV_HEADS = NSA_HEADS // 4
NSA_GROUP = NSA_HEADS // NSA_KV_HEADS
NSA_KV_W = NSA_KV_HEADS * NSA_HEAD_DIM
CMP_BLOCK = 32
CMP_STRIDE = 16
CMP_HIDDEN = 256
SLC_BLOCK = 64
SLC_TOPK = 8
WINDOW = 256
Q_BLOCK = 128
MEM_LEN = 256
MEM_HEADS = 4
MEM_HEAD_DIM = D_BR // MEM_HEADS
REL_BUCKETS = 32
REL_MAX_DIST = 1024
DN_ALPHA = (2 * DEPTH) ** 0.25
DN_BETA = (8 * DEPTH) ** -0.25
LN_EPS = 1e-5
IN_WIDTH = 9 * D_BR + 6 * NSA_KV_W + 3 * NSA_HEADS + N_BRANCHES * D_MODEL

kernel_name = "hybrid_gated_gmlp_rglru_nsa_mem_deepnorm"


def in_split_points():
    sizes = (D_BR, D_BR, D_BR, D_BR, D_BR, D_BR,
             NSA_KV_W, NSA_KV_W, NSA_KV_W, NSA_KV_W, NSA_KV_W, NSA_KV_W,
             3 * NSA_HEADS, D_BR, D_BR, D_BR, N_BRANCHES * D_MODEL)
    return tuple(int(v) for v in np.cumsum(sizes)[:-1])


def layer_norm(x, g, b):
    xf = x.astype(jnp.float32)
    mu = jnp.mean(xf, -1, keepdims=True)
    var = jnp.mean(jnp.square(xf - mu), -1, keepdims=True)
    return ((xf - mu) * lax.rsqrt(var + LN_EPS) * g + b).astype(x.dtype)


def masked_softmax(s, mask):
    s = jnp.where(mask, s.astype(jnp.float32), -1e30)
    m = jnp.max(s, axis=-1, keepdims=True)
    p = jnp.where(mask, jnp.exp(s - m), 0.0)
    return p / jnp.maximum(jnp.sum(p, -1, keepdims=True), 1e-30)


def rel_bucket(dist):
    n = jnp.maximum(dist, 0)
    exact = REL_BUCKETS // 2
    nf = jnp.maximum(n, 1).astype(jnp.float32)
    large = exact + (jnp.log(nf / exact) / math.log(REL_MAX_DIST / exact)
                     * (REL_BUCKETS - exact)).astype(jnp.int32)
    return jnp.where(n < exact, n, jnp.minimum(large, REL_BUCKETS - 1))


def gmlp_spatial_gating(u, v, ln_g, ln_b, w_s, b_s):
    bsz, seq, _ = u.shape
    u = jax.nn.gelu(u)
    v = layer_norm(jax.nn.gelu(v), ln_g, ln_b)
    vc = v.reshape(bsz, seq // GMLP_CHUNK, GMLP_CHUNK, GMLP_GROUPS, GMLP_GROUP_DIM)
    causal = jnp.tril(jnp.ones((GMLP_CHUNK, GMLP_CHUNK), dtype=bool))
    w = jnp.where(causal, w_s, 0).astype(v.dtype)
    mixed = jnp.einsum('gts,bcsgd->bctgd', w, vc) + jnp.swapaxes(b_s, 0, 1)[:, :, None]
    return u * mixed.reshape(bsz, seq, D_BR)


def causal_depthwise_conv(x, w, b):
    out = lax.conv_general_dilated(
        x, w[:, None, :].astype(x.dtype), window_strides=(1,),
        padding=[(CONV_WIDTH - 1, 0)], dimension_numbers=('NWC', 'WIO', 'NWC'),
        feature_group_count=x.shape[-1])
    return out + b


def block_diag_linear(x, w, b):
    bsz, seq, _ = x.shape
    xb = x.reshape(bsz, seq, LRU_BLOCKS, LRU_BLOCK_DIM)
    return jnp.einsum('bsnd,nde->bsne', xb, w).reshape(bsz, seq, D_BR) + b


def rg_lru(x, wa, ba, wx, bx, lam):
    f32 = jnp.float32
    r = jax.nn.sigmoid(block_diag_linear(x, wa, ba).astype(f32))
    i = jax.nn.sigmoid(block_diag_linear(x, wx, bx).astype(f32))
    log_a = -LRU_C * r * jax.nn.softplus(-lam.astype(f32))
    a = jnp.exp(log_a)
    gated = jnp.sqrt(-jnp.expm1(2.0 * log_a)) * i * x.astype(f32)

    def combine(lhs, rhs):
        a1, b1 = lhs
        a2, b2 = rhs
        return a1 * a2, a2 * b1 + b2

    _, h = lax.associative_scan(combine, (a, gated), axis=1)
    return h.astype(x.dtype)


def nsa_attention(q, k_c, v_c, k_s, v_s, k_w, v_w, gate_logits, gate_b, rel_table,
                  pe_k, pe_v, w1_k, w1_v, w2_k, w2_v):
    f32 = jnp.float32
    bsz, seq, _ = q.shape
    dk = NSA_HEAD_DIM
    pos = jnp.arange(seq)
    tab = rel_table.reshape(REL_BUCKETS, NSA_KV_HEADS, NSA_GROUP)

    def heads_kv(t):
        return t.reshape(bsz, seq, NSA_KV_HEADS, dk).transpose(0, 2, 1, 3)

    qh = q.reshape(bsz, seq, NSA_KV_HEADS, NSA_GROUP, dk).transpose(0, 2, 3, 1, 4) * (dk ** -0.5)
    k_c, v_c, k_s, v_s, k_w, v_w = (heads_kv(t) for t in (k_c, v_c, k_s, v_s, k_w, v_w))

    def compress(t, pe, w1, w2):
        t16 = t.reshape(bsz, NSA_KV_HEADS, seq // CMP_STRIDE, CMP_STRIDE, dk)
        blocks = jnp.concatenate([t16[:, :, :-1], t16[:, :, 1:]], axis=3) + pe
        flat = blocks.reshape(blocks.shape[:3] + (CMP_BLOCK * dk,))
        return jax.nn.silu(flat @ w1) @ w2

    kc = compress(k_c, pe_k, w1_k, w2_k)
    vc = compress(v_c, pe_v, w1_v, w2_v)
    n_cmp = kc.shape[2]
    c_start = jnp.arange(n_cmp) * CMP_STRIDE
    dist_c = pos[:, None] - (c_start + CMP_BLOCK - 1)[None, :]
    bias_c = jnp.moveaxis(tab[rel_bucket(dist_c)], (-2, -1), (0, 1))
    s_c = jnp.einsum('bhgsd,bhnd->bhgsn', qh, kc).astype(f32) + bias_c
    p_c = masked_softmax(s_c, dist_c >= 0)
    o_c = jnp.einsum('bhgsn,bhnd->bhgsd', p_c.astype(vc.dtype), vc)

    n_slc = seq // SLC_BLOCK
    s_start = jnp.arange(n_slc) * SLC_BLOCK
    overlap = jnp.clip(
        jnp.minimum(c_start[:, None] + CMP_BLOCK, s_start[None, :] + SLC_BLOCK)
        - jnp.maximum(c_start[:, None], s_start[None, :]), 0, None).astype(f32) / CMP_BLOCK
    imp = jnp.einsum('bhgsn,nj->bhsj', p_c, overlap)
    q_blk = pos // SLC_BLOCK
    j = jnp.arange(n_slc)
    forced = (j[None, :] == 0) | (j[None, :] == q_blk[:, None]) | (j[None, :] == q_blk[:, None] - 1)
    future = j[None, :] > q_blk[:, None]
    imp = jnp.where(future, -jnp.inf, jnp.where(forced, jnp.inf, imp))
    top_k = min(SLC_TOPK, n_slc)
    _, sel = lax.top_k(imp, top_k)

    k_sb = k_s.reshape(bsz, NSA_KV_HEADS, n_slc, SLC_BLOCK, dk)
    v_sb = v_s.reshape(bsz, NSA_KV_HEADS, n_slc, SLC_BLOCK, dk)
    k_wp = jnp.pad(k_w, ((0, 0), (0, 0), (WINDOW, 0), (0, 0)))
    v_wp = jnp.pad(v_w, ((0, 0), (0, 0), (WINDOW, 0), (0, 0)))
    n_qb = seq // Q_BLOCK
    b_ix = jnp.arange(bsz)[:, None, None, None]
    h_ix = jnp.arange(NSA_KV_HEADS)[None, :, None, None]
    tab_kv = jnp.transpose(tab, (1, 0, 2))
    offs = jnp.arange(SLC_BLOCK)
    win_offs = jnp.arange(WINDOW + Q_BLOCK)

    def block_step(args):
        qb, q_b, sel_b = args
        tq = qb * Q_BLOCK + jnp.arange(Q_BLOCK)
        ks = k_sb[b_ix, h_ix, sel_b]
        vs = v_sb[b_ix, h_ix, sel_b]
        kpos = sel_b[..., None] * SLC_BLOCK + offs
        dist = tq[:, None, None] - kpos
        bias = tab_kv[h_ix[..., None], rel_bucket(dist)]
        bias = jnp.moveaxis(bias, -1, 2).reshape(bsz, NSA_KV_HEADS, NSA_GROUP, Q_BLOCK, top_k * SLC_BLOCK)
        s = jnp.einsum('bhgqd,bhqnkd->bhgqnk', q_b, ks).astype(f32).reshape(
            bsz, NSA_KV_HEADS, NSA_GROUP, Q_BLOCK, top_k * SLC_BLOCK) + bias
        mask = (dist >= 0).reshape(bsz, NSA_KV_HEADS, 1, Q_BLOCK, top_k * SLC_BLOCK)
        p = masked_softmax(s, mask).reshape(bsz, NSA_KV_HEADS, NSA_GROUP, Q_BLOCK, top_k, SLC_BLOCK)
        o_s = jnp.einsum('bhgqnk,bhqnkd->bhgqd', p.astype(vs.dtype), vs)

        kw = lax.dynamic_slice_in_dim(k_wp, qb * Q_BLOCK, WINDOW + Q_BLOCK, axis=2)
        vw = lax.dynamic_slice_in_dim(v_wp, qb * Q_BLOCK, WINDOW + Q_BLOCK, axis=2)
        kpos_w = qb * Q_BLOCK - WINDOW + win_offs
        dist_w = tq[:, None] - kpos_w[None, :]
        mask_w = (dist_w >= 0) & (dist_w < WINDOW) & (kpos_w[None, :] >= 0)
        bias_w = jnp.moveaxis(tab[rel_bucket(dist_w)], (-2, -1), (0, 1))
        s_w = jnp.einsum('bhgqd,bhkd->bhgqk', q_b, kw).astype(f32) + bias_w
        p_w = masked_softmax(s_w, mask_w)
        o_w = jnp.einsum('bhgqk,bhkd->bhgqd', p_w.astype(vw.dtype), vw)
        return o_s, o_w

    q_blocks = jnp.moveaxis(qh.reshape(bsz, NSA_KV_HEADS, NSA_GROUP, n_qb, Q_BLOCK, dk), 3, 0)
    sel_blocks = jnp.moveaxis(sel.reshape(bsz, NSA_KV_HEADS, n_qb, Q_BLOCK, top_k), 2, 0)
    o_s, o_w = lax.map(block_step, (jnp.arange(n_qb), q_blocks, sel_blocks))
    o_s = jnp.moveaxis(o_s, 0, 3).reshape(bsz, NSA_KV_HEADS, NSA_GROUP, seq, dk)
    o_w = jnp.moveaxis(o_w, 0, 3).reshape(bsz, NSA_KV_HEADS, NSA_GROUP, seq, dk)

    g = jax.nn.sigmoid(gate_logits.astype(f32) + gate_b)
    g = g.reshape(bsz, seq, 3, NSA_KV_HEADS, NSA_GROUP).transpose(2, 0, 3, 4, 1)[..., None]
    o = g[0] * o_c + g[1] * o_s + g[2] * o_w
    return o.transpose(0, 3, 1, 2, 4).reshape(bsz, seq, D_BR).astype(q.dtype)


def memory_attention(q, mem, w_kv):
    bsz, seq, _ = q.shape
    k, v = jnp.split(mem @ w_kv, 2, axis=-1)
    k = k.reshape(bsz, -1, MEM_HEADS, MEM_HEAD_DIM)
    v = v.reshape(bsz, -1, MEM_HEADS, MEM_HEAD_DIM)
    qh = q.reshape(bsz, seq, MEM_HEADS, MEM_HEAD_DIM) * (MEM_HEAD_DIM ** -0.5)
    p = jax.nn.softmax(jnp.einsum('bshd,bmhd->bhsm', qh, k).astype(jnp.float32), axis=-1)
    return jnp.einsum('bhsm,bmhd->bshd', p.astype(v.dtype), v).reshape(bsz, seq, D_BR)


def setup_inputs(seed: int = 0) -> dict:
    key = jax.random.key(seed)
    ks = jax.random.split(key, 32)
    f32 = jnp.float32
    dk = NSA_HEAD_DIM

    def nrm(k, shape, scale):
        return jax.random.normal(k, shape, f32) * scale

    a_pow = jax.random.uniform(ks[14], (DEPTH, D_BR), f32, 0.9, 0.999)
    a_base = a_pow ** (1.0 / LRU_C)
    lru_lambda = jnp.log(a_base) - jnp.log1p(-a_base)
    return {
        "x": nrm(ks[0], (BATCH, SEQ, D_MODEL), 1.0),
        "mem": nrm(ks[1], (BATCH, MEM_LEN, D_MODEL), 1.0),
        "rel_bias": nrm(ks[2], (REL_BUCKETS, NSA_HEADS), 0.5),
        "w_in": nrm(ks[3], (DEPTH, D_MODEL, IN_WIDTH), D_MODEL ** -0.5),
        "sgu_ln_g": 1.0 + nrm(ks[4], (DEPTH, D_BR), 0.01),
        "sgu_ln_b": nrm(ks[5], (DEPTH, D_BR), 0.01),
        "sgu_w": nrm(ks[6], (DEPTH, GMLP_GROUPS, GMLP_CHUNK, GMLP_CHUNK), GMLP_CHUNK ** -0.5),
        "sgu_b": 1.0 + nrm(ks[7], (DEPTH, GMLP_GROUPS, GMLP_CHUNK), 0.01),
        "conv_w": nrm(ks[8], (DEPTH, CONV_WIDTH, D_BR), CONV_WIDTH ** -0.5),
        "conv_b": nrm(ks[9], (DEPTH, D_BR), 0.01),
        "lru_wa": nrm(ks[10], (DEPTH, LRU_BLOCKS, LRU_BLOCK_DIM, LRU_BLOCK_DIM), LRU_BLOCK_DIM ** -0.5),
        "lru_ba": nrm(ks[11], (DEPTH, D_BR), 0.01),
        "lru_wx": nrm(ks[12], (DEPTH, LRU_BLOCKS, LRU_BLOCK_DIM, LRU_BLOCK_DIM), LRU_BLOCK_DIM ** -0.5),
        "lru_bx": nrm(ks[13], (DEPTH, D_BR), 0.01),
        "lru_lambda": lru_lambda,
        "cmp_pe_k": nrm(ks[15], (DEPTH, CMP_BLOCK, dk), 0.1),
        "cmp_pe_v": nrm(ks[16], (DEPTH, CMP_BLOCK, dk), 0.1),
        "cmp_w1_k": nrm(ks[17], (DEPTH, CMP_BLOCK * dk, CMP_HIDDEN), (CMP_BLOCK * dk) ** -0.5),
        "cmp_w1_v": nrm(ks[18], (DEPTH, CMP_BLOCK * dk, CMP_HIDDEN), (CMP_BLOCK * dk) ** -0.5),
        "cmp_w2_k": nrm(ks[19], (DEPTH, CMP_HIDDEN, dk), CMP_HIDDEN ** -0.5),
        "cmp_w2_v": nrm(ks[20], (DEPTH, CMP_HIDDEN, dk), CMP_HIDDEN ** -0.5),
        "nsa_gate_b": nrm(ks[21], (DEPTH, 3 * NSA_HEADS), 0.01),
        "w_mem_kv": nrm(ks[22], (DEPTH, D_MODEL, 2 * D_BR), D_MODEL ** -0.5),
        "w_branch": nrm(ks[23], (DEPTH, N_BRANCHES, D_BR, D_MODEL), DN_BETA * D_BR ** -0.5),
        "w_out": nrm(ks[24], (DEPTH, D_MODEL, D_MODEL), DN_BETA * D_MODEL ** -0.5),
        "ln_g": 1.0 + nrm(ks[25], (DEPTH, D_MODEL), 0.01),
        "ln_b": nrm(ks[26], (DEPTH, D_MODEL), 0.01),
    }


def reference(x, mem, rel_bias, w_in, sgu_ln_g, sgu_ln_b, sgu_w, sgu_b, conv_w, conv_b,
              lru_wa, lru_ba, lru_wx, lru_bx, lru_lambda, cmp_pe_k, cmp_pe_v, cmp_w1_k, cmp_w1_v,
              cmp_w2_k, cmp_w2_v, nsa_gate_b, w_mem_kv, w_branch, w_out, ln_g, ln_b):
    bsz, seq, _ = x.shape
    split_points = in_split_points()
    for l in range(DEPTH):
        h = x @ w_in[l]
        (u_a, v_a, g_a, x_b, g_b, q_c, kc_c, vc_c, ks_c, vs_c, kw_c, vw_c, gl_c, g_c,
         q_m, g_m, g_merge) = jnp.split(h, split_points, axis=-1)

        o_a = gmlp_spatial_gating(u_a, v_a, sgu_ln_g[l], sgu_ln_b[l], sgu_w[l], sgu_b[l]) * jax.nn.silu(g_a)
        x_conv = causal_depthwise_conv(x_b, conv_w[l], conv_b[l])
        o_b = rg_lru(x_conv, lru_wa[l], lru_ba[l], lru_wx[l], lru_bx[l], lru_lambda[l]) * jax.nn.silu(g_b)
        o_c = nsa_attention(q_c, kc_c, vc_c, ks_c, vs_c, kw_c, vw_c, gl_c, nsa_gate_b[l], rel_bias,
                            cmp_pe_k[l], cmp_pe_v[l], cmp_w1_k[l], cmp_w1_v[l],
                            cmp_w2_k[l], cmp_w2_v[l]) * jax.nn.silu(g_c)
        o_m = memory_attention(q_m, mem, w_mem_kv[l]) * jax.nn.silu(g_m)

        gates = jax.nn.sigmoid(g_merge.reshape(bsz, seq, N_BRANCHES, D_MODEL))
        merged = gates[:, :, 0] * (o_a @ w_branch[l, 0])
        merged = merged + gates[:, :, 1] * (o_b @ w_branch[l, 1])
        merged = merged + gates[:, :, 2] * (o_c @ w_branch[l, 2])
        merged = merged + gates[:, :, 3] * (o_m @ w_branch[l, 3])
        y = merged @ w_out[l]
        x = layer_norm(DN_ALPHA * x + y, ln_g[l], ln_b[l])
    return x
```

```cpp
#include <hip/hip_runtime.h>
#include <hip/hip_cooperative_groups.h>
#include <cstdio>
namespace cg = cooperative_groups;

#define LAS __attribute__((address_space(3)))
typedef unsigned short bf16_t;
typedef short bf16x8 __attribute__((ext_vector_type(8)));
typedef float f32x4 __attribute__((ext_vector_type(4)));
typedef unsigned u32x4 __attribute__((ext_vector_type(4)));
typedef unsigned u32x2 __attribute__((ext_vector_type(2)));

constexpr int SEQ = 4096, MT = 16384, DM = 2048, DBR = 1024, NIN = 19200  , LDH = 11008  , INW = 18992;
constexpr int C_U = 0, C_V = 1024, C_GA = 2048, C_XB = 3072, C_GB = 4096, C_Q = 5120, C_KC = 6144, C_VC = 6400, C_KS = 6656, C_VS = 6912,
              C_KW = 7168, C_VW = 7424, C_GC = 7680, C_QM = 8704, C_GM = 9728, C_GL = 10752  , N_GMG = 10752, N_GL = 18944  ;
constexpr float LOG2E = 1.4426950408889634f;
constexpr float NEGBIG = -1e30f;

constexpr size_t WS_XB   = 4096;
constexpr size_t WS_WIN  = WS_XB   + (size_t)MT * DM * 2;
constexpr size_t WS_WBR  = WS_WIN  + (size_t)NIN * DM * 2;
constexpr size_t WS_WOUT = WS_WBR  + (size_t)4 * DM * DBR * 2;
constexpr size_t WS_WMEM = WS_WOUT + (size_t)DM * DM * 2;
constexpr size_t WS_MEMB = WS_WMEM + (size_t)DM * DM * 2;
constexpr size_t WS_W1T  = WS_MEMB + (size_t)1024 * DM * 2;
constexpr size_t WS_WAT  = WS_W1T  + (size_t)2 * 256 * 2048 * 2;
constexpr size_t WS_SGW  = WS_WAT  + (size_t)2 * 8 * 128 * 128 * 2;
constexpr size_t WS_LUT  = WS_SGW  + (size_t)8 * 128 * 128 * 2;
constexpr size_t WS_PEW1 = WS_LUT  + (size_t)16 * 4096 * 4;
constexpr size_t WS_H    = WS_PEW1 + 8192;
constexpr size_t WS_MKV  = WS_H    + (size_t)MT * LDH * 2;
constexpr size_t WS_LRA  = WS_MKV  + (size_t)1024 * DM * 2;
constexpr size_t WS_LRG  = WS_LRA  + (size_t)MT * DBR * 4;
constexpr size_t WS_O    = WS_LRG  + (size_t)MT * DBR * 4;
constexpr size_t WS_A0   = WS_O    + (size_t)4 * MT * DBR * 2;
constexpr size_t WS_HID  = WS_A0   + (size_t)2 * 4096 * 2048 * 2;
constexpr size_t WS_KCV  = WS_HID  + (size_t)2 * 4096 * 256 * 2;
constexpr size_t WS_AGG  = WS_KCV  + (size_t)2 * 4096 * 64 * 2;
constexpr size_t WS_PARK = WS_AGG  + (size_t)2 * 128 * 1024 * 4;
constexpr size_t WS_G8   = WS_PARK + (size_t)256 * 8 * 8 * 64 * 16;
constexpr size_t WS_XB2  = WS_G8   + (size_t)MT * 8192;
constexpr size_t WS_LNX  = WS_XB2  + (size_t)MT * DM * 2;
constexpr size_t WS_END  = WS_LNX  + (size_t)64 * 256 * 8 * 8;

constexpr int LDS_BYTES = 147456, PL_OFF = 147200;

struct Params {
    const float* in[27];
    float* out;
    unsigned char* ws;
    int ph_lo, ph_hi;
};
typedef unsigned long long u64_t;
struct InAcc { const LAS u64_t* pl;
    __device__ __forceinline__ const float* operator[](int k) const { const u64_t v = pl[k];
        const unsigned lo = __builtin_amdgcn_readfirstlane((unsigned)v), hi = __builtin_amdgcn_readfirstlane((unsigned)(v >> 32)); return (const float*)(const __attribute__((address_space(1))) float*)(((u64_t)hi << 32) | lo); } };
struct Ctx { InAcc in; float* out; unsigned char* ws; };

__device__ __forceinline__ unsigned cvt_pk_bf16(float lo, float hi) { unsigned r; asm("v_cvt_pk_bf16_f32 %0, %1, %2" : "=v"(r) : "v"(lo), "v"(hi)); return r; }
__device__ __forceinline__ float bflo(unsigned w) { return __uint_as_float(w << 16); }
__device__ __forceinline__ float bfhi(unsigned w) { return __uint_as_float(w & 0xffff0000u); }
__device__ __forceinline__ float bf2f(bf16_t v) { return __uint_as_float(((unsigned)v) << 16); }
__device__ __forceinline__ float sigmoidf_(float x) { return __builtin_amdgcn_rcpf(1.0f + __expf(-x)); }
__device__ __forceinline__ float siluf_(float x) { return x * __builtin_amdgcn_rcpf(1.0f + __expf(-x)); }
__device__ __forceinline__ float gelu_tanh(float x) { const float u = 0.7978845608028654f * (x + 0.044715f * x * x * x); return x * __builtin_amdgcn_rcpf(1.0f + __expf(-2.0f * u)); }
__device__ __forceinline__ float wave_sum(float v) {
#pragma unroll
    for (int o = 32; o >= 1; o >>= 1) v += __shfl_xor(v, o);
    return v; }
__device__ __forceinline__ float wave_max(float v) {
#pragma unroll
    for (int o = 32; o >= 1; o >>= 1) v = fmaxf(v, __shfl_xor(v, o));
    return v; }
__device__ __forceinline__ int opaque_tid() { int t = threadIdx.x; asm volatile("" : "+v"(t)); return t; }
__device__ __forceinline__ f32x4 mfma16(bf16x8 a, bf16x8 b, f32x4 c) { return __builtin_amdgcn_mfma_f32_16x16x32_bf16(a, b, c, 0, 0, 0); }
__device__ __forceinline__ int rel_bucket(int n) {
    if (n < 16) return n < 0 ? 0 : n;
    return 16 + (n >= 21) + (n >= 27) + (n >= 35) + (n >= 46) + (n >= 59) + (n >= 77) + (n >= 99) + (n >= 128) + (n >= 166) + (n >= 216) + (n >= 280) + (n >= 363) + (n >= 470) + (n >= 609) + (n >= 790);
}

namespace pg8 {
constexpr int BM = 256, BK = 64, HALF = 128, HTB = HALF * BK * 2, STAGE_BYTES = 8 * HTB, NXCD = 8, WGM = 8;
__device__ __forceinline__ int lds_byte(int r, int c) { const int st = (r >> 4) * 2 + (c >> 5), rr = r & 15, cc = c & 31, ob = rr * 64 + cc * 2; return st * 1024 + (ob ^ (((ob >> 9) & 1) << 5)); }
__device__ __forceinline__ void stage_rc(int b, int& R, int& C) { const int st = b / 1024, sb = b % 1024, swz = sb ^ (((sb >> 9) & 1) << 5); R = (st >> 1) * 16 + swz / 64; C = (st & 1) * 32 + (swz % 64) / 2; }
__device__ __forceinline__ int perm32(int rho) { const int n = rho >> 4, i = rho & 15; return 8 * (i >> 2) + 4 * n + (i & 3); }
struct Unit { int pm, pn, z; };

__device__ __forceinline__ bool static_next(long L, int nM, int nN, Unit& u) {
    const int nwg = nM * nN; if (L >= nwg) return false;
    int wgid = (int)L; { const int q = nwg / NXCD, r = nwg % NXCD, xcd = wgid % NXCD, off = wgid / NXCD; wgid = (xcd < r ? xcd * (q + 1) : r * (q + 1) + (xcd - r) * q) + off; }
    const int nig = WGM * nN, gid = wgid / nig, fm = gid * WGM, gsz = (nM - fm) < WGM ? (nM - fm) : WGM;
    u.pm = fm + ((wgid % nig) % gsz); u.pn = (wgid % nig) / gsz; u.z = 0; return true;
}
struct SchedStd {
    int nM, nN, G, c, K; const bf16_t* A; const bf16_t* B;
    __device__ __forceinline__ bool next(int i, Unit& u) const { return static_next((long)i * G + c, nM, nN, u); }
    __device__ __forceinline__ const char* aptr(const Unit& u) const { return (const char*)(A + (size_t)u.pm * 256 * K); }
    __device__ __forceinline__ const char* bptr(const Unit& u) const { return (const char*)(B + (size_t)u.pn * 256 * K); }
};
struct SchedCmp1 {
    int c; const bf16_t* A0; const bf16_t* W1T;
    __device__ __forceinline__ bool next(int i, Unit& u) const { if (i > 0 || c >= 32) return false; u.z = c >> 4; u.pm = c & 15; u.pn = 0; return true; }
    __device__ __forceinline__ const char* aptr(const Unit& u) const { return (const char*)(A0 + ((size_t)u.z * 4096 + (size_t)u.pm * 256) * 2048); }
    __device__ __forceinline__ const char* bptr(const Unit& u) const { return (const char*)(W1T + (size_t)u.z * 256 * 2048); }
};
struct SchedMerge {
    int G, c; const bf16_t* O; const bf16_t* WBR;
    __device__ __forceinline__ bool next(int i, Unit& u) const { const bool ok = static_next((long)(i >> 2) * G + c, 64, 8, u); u.z = i & 3; return ok; }
    __device__ __forceinline__ const char* aptr(const Unit& u) const { return (const char*)(O + ((size_t)u.z * MT + (size_t)u.pm * 256) * DBR); }
    __device__ __forceinline__ const char* bptr(const Unit& u) const { return (const char*)(WBR + ((size_t)u.z * DM + (size_t)u.pn * 256) * DBR); }
};

struct SchedOut {
    int c; const bf16_t* A; const bf16_t* B;
    __device__ __forceinline__ bool next(int i, Unit& u) const { if (i > 1) return false; const int x = c & 7, k = c >> 3; u.pm = 32 * i + 4 * x + (k >> 3); u.pn = k & 7; u.z = 0; return true; }
    __device__ __forceinline__ const char* aptr(const Unit& u) const { return (const char*)(A + (size_t)u.pm * 256 * DM); }
    __device__ __forceinline__ const char* bptr(const Unit& u) const { return (const char*)(B + (size_t)u.pn * 256 * DM); }
};
template <class Epi, class Sched>
__device__ __forceinline__ void gemm_phase(LAS unsigned char* lds, const int K, const Sched& S, const Epi& E) {
    const int tid = opaque_tid(), wid = __builtin_amdgcn_readfirstlane(tid >> 6), lane = tid & 63, wr = wid >> 2, wc = wid & 3, fr = lane & 15, fq = lane >> 4;
    const int nt = K / BK;
    unsigned voffA[2], voffB[2];
#pragma unroll
    for (int i = 0; i < 2; ++i) { int R, C; stage_rc(tid * 16 + i * 8192, R, C); const int Rb = Epi::PERM ? ((R & ~31) + perm32(R & 31)) : R;
        voffA[i] = (unsigned)(R * K + C) * 2u; voffB[i] = (unsigned)(Rb * K + C) * 2u; }
    const size_t kstep = (size_t)(BK * 2);
    const size_t hstep = (size_t)HALF * K * 2;
    const unsigned ldsw = (unsigned)wid * 1024u;
    const int aoff = lds_byte(wr * 64 + fr, fq * 8), boff = lds_byte(wc * 32 + fr, fq * 8);
#define PG8_SA(b, h) (((b) * 2 + (h)) * HTB)
#define PG8_SB(b, h) ((4 + (b) * 2 + (h)) * HTB)
#define PG8_STAGE(bufoff, gbase, voff) do { _Pragma("unroll") for (int _i = 0; _i < 2; ++_i) \
        __builtin_amdgcn_global_load_lds((const unsigned*)((const char*)(gbase) + (voff)[_i]), (LAS unsigned*)(lds + (bufoff) + ldsw + _i * 8192), 16, 0, 0); } while (0)
#define PG8_LDA(dst, b, h) do { _Pragma("unroll") for (int m = 0; m < 4; ++m) _Pragma("unroll") for (int k = 0; k < 2; ++k) dst[m][k] = *(const LAS bf16x8*)(lds + PG8_SA(b, h) + aoff + m * 2048 + k * 1024); } while (0)
#define PG8_LDB(dst, b, h) do { _Pragma("unroll") for (int n = 0; n < 2; ++n) _Pragma("unroll") for (int k = 0; k < 2; ++k) dst[n][k] = *(const LAS bf16x8*)(lds + PG8_SB(b, h) + boff + n * 2048 + k * 1024); } while (0)
#define PG8_MMA(ai, bj, At, Bt) do { __builtin_amdgcn_s_setprio(1); _Pragma("unroll") for (int m = 0; m < 4; ++m) _Pragma("unroll") for (int n = 0; n < 2; ++n) _Pragma("unroll") for (int k = 0; k < 2; ++k) \
        acc[ai][bj][m][n] = __builtin_amdgcn_mfma_f32_16x16x32_bf16(Bt[n][k], At[m][k], acc[ai][bj][m][n], 0, 0, 0); __builtin_amdgcn_s_setprio(0); } while (0)
#define PG8_WAIT_V(n) asm volatile("s_waitcnt vmcnt(" #n ")" ::: "memory")
#define PG8_WAIT_L(n) asm volatile("s_waitcnt lgkmcnt(" #n ")" ::: "memory")
#define PG8_BAR __builtin_amdgcn_s_barrier()
#define PG8_SCHED __builtin_amdgcn_sched_barrier(0)
    Unit cur, nxt; int ui = 0;
    if (!S.next(0, cur)) return;
    f32x4 acc[2][2][4][2];
#pragma unroll
    for (int a = 0; a < 2; ++a)
#pragma unroll
        for (int b = 0; b < 2; ++b)
#pragma unroll
            for (int m = 0; m < 4; ++m)
#pragma unroll
                for (int n = 0; n < 2; ++n) acc[a][b][m][n] = (f32x4){0.f, 0.f, 0.f, 0.f};
    bf16x8 At[4][2], B0[2][2], B1[2][2];
    const char* cA = S.aptr(cur); const char* cB = S.bptr(cur);
    PG8_STAGE(PG8_SB(0, 0), cB, voffB); PG8_STAGE(PG8_SB(0, 1), cB + hstep, voffB); PG8_STAGE(PG8_SA(0, 0), cA, voffA); PG8_STAGE(PG8_SA(0, 1), cA + hstep, voffA);
    if (wr == 1) PG8_BAR;
    PG8_WAIT_V(2); PG8_BAR;
    PG8_STAGE(PG8_SB(1, 0), cB + kstep, voffB); PG8_STAGE(PG8_SA(1, 0), cA + kstep, voffA); PG8_STAGE(PG8_SB(1, 1), cB + hstep + kstep, voffB);
    PG8_WAIT_V(6); PG8_BAR;
    for (;;) {
        const bool has_next = S.next(ui + 1, nxt);
        const char* nA = has_next ? S.aptr(nxt) : cA; const char* nB = has_next ? S.bptr(nxt) : cB;
        for (int t = 0; t < nt; t += 2) {
            const bool last = (t == nt - 2);
            const char* a1 = cA + (size_t)(t + 1) * kstep;
            const char* a2 = last ? nA : cA + (size_t)(t + 2) * kstep; const char* b2 = last ? nB : cB + (size_t)(t + 2) * kstep;
            const char* a3 = a2 + kstep; const char* b3 = b2 + kstep;
            PG8_LDB(B0, 0, 0); PG8_LDB(B1, 0, 1); PG8_SCHED; PG8_LDA(At, 0, 0); PG8_STAGE(PG8_SA(1, 1), a1 + hstep, voffA);
            PG8_WAIT_V(8); PG8_WAIT_L(0); PG8_BAR; PG8_MMA(0, 0, At, B0); PG8_MMA(0, 1, At, B1); PG8_BAR; PG8_SCHED;
            PG8_LDA(At, 0, 1); PG8_STAGE(PG8_SB(0, 0), b2, voffB); PG8_STAGE(PG8_SB(0, 1), b2 + hstep, voffB); PG8_STAGE(PG8_SA(0, 0), a2, voffA);
            PG8_WAIT_V(8); PG8_WAIT_L(0); PG8_BAR; PG8_MMA(1, 0, At, B0); PG8_MMA(1, 1, At, B1); PG8_BAR; PG8_SCHED;
            PG8_LDB(B0, 1, 0); PG8_LDB(B1, 1, 1); PG8_SCHED; PG8_LDA(At, 1, 0); PG8_STAGE(PG8_SA(0, 1), a2 + hstep, voffA);
            PG8_WAIT_V(8); PG8_WAIT_L(0); PG8_BAR; PG8_MMA(0, 0, At, B0); PG8_MMA(0, 1, At, B1); PG8_BAR; PG8_SCHED;
            PG8_LDA(At, 1, 1); PG8_STAGE(PG8_SB(1, 0), b3, voffB); PG8_STAGE(PG8_SB(1, 1), b3 + hstep, voffB); PG8_STAGE(PG8_SA(1, 0), a3, voffA);
            PG8_WAIT_V(8); PG8_WAIT_L(0); PG8_BAR; PG8_MMA(1, 0, At, B0); PG8_MMA(1, 1, At, B1); PG8_BAR; PG8_SCHED;
        }
        if (wr == 0) PG8_BAR;
        E(acc, cur, wr, wc, fr, fq);
        if (!has_next) break;
#pragma unroll
        for (int a = 0; a < 2; ++a)
#pragma unroll
            for (int b = 0; b < 2; ++b)
#pragma unroll
                for (int m = 0; m < 4; ++m)
#pragma unroll
                    for (int n = 0; n < 2; ++n) acc[a][b][m][n] = (f32x4){0.f, 0.f, 0.f, 0.f};
        cur = nxt; cA = nA; cB = nB; ++ui;
        if (wr == 1) PG8_BAR;
    }
    PG8_WAIT_V(0);
    PG8_BAR;
#undef PG8_SA
#undef PG8_SB
#undef PG8_STAGE
#undef PG8_LDA
#undef PG8_LDB
#undef PG8_MMA
#undef PG8_WAIT_V
#undef PG8_WAIT_L
#undef PG8_BAR
#undef PG8_SCHED
}

__device__ __forceinline__ int act_of(int col) {
    if (col < 2048) return 1; if (col < 3072) return 2; if (col < 4096) return 0; if (col < 5120) return 2; if (col < 7680) return 0;
    if (col < 8704) return 2; if (col < 9728) return 0; if (col < 10752) return 2; if (col < 18944) return 3; return 0;
}
struct EpiInProj {
    static constexpr bool PERM = true;
    bf16_t* H; unsigned char* G8;
    __device__ __forceinline__ void operator()(const f32x4 (&acc)[2][2][4][2], const Unit& u, int wr, int wc, int fr, int fq) const {
        const int row0 = u.pm * BM + wr * 64 + fr, colt = u.pn * BM;
        const int act = act_of(colt);
        if (act == 3) {
            unsigned char* gp = G8 + (colt - N_GMG) + wc * 32 + 8 * fq;
#pragma unroll
            for (int ai = 0; ai < 2; ++ai)
#pragma unroll
                for (int m = 0; m < 4; ++m) { unsigned char* rowp = gp + (size_t)(row0 + ai * HALF + m * 16) * 8192;
#pragma unroll
                    for (int bj = 0; bj < 2; ++bj) { unsigned q[8];
#pragma unroll
                        for (int n = 0; n < 2; ++n)
#pragma unroll
                            for (int j = 0; j < 4; j += 2) { typedef float f32x2 __attribute__((ext_vector_type(2)));
                                const f32x2 x = {acc[ai][bj][m][n][j], acc[ai][bj][m][n][j + 1]}; const f32x2 t = x * (-LOG2E);
                                f32x2 d = {__builtin_amdgcn_exp2f(t.x), __builtin_amdgcn_exp2f(t.y)}; d = d + 1.0f;
                                f32x2 r = {__builtin_amdgcn_rcpf(d.x), __builtin_amdgcn_rcpf(d.y)}; r = r * 255.0f + 0.5f;
                                q[4 * n + j] = (unsigned)r.x; q[4 * n + j + 1] = (unsigned)r.y; }
                        u32x2 w; w.x = q[0] | (q[1] << 8) | (q[2] << 16) | (q[3] << 24); w.y = q[4] | (q[5] << 8) | (q[6] << 16) | (q[7] << 24);
                        *(u32x2*)(rowp + bj * HALF) = w; } }
            return;
        }
        const int col0 = (colt >= N_GL ? C_GL : colt) + wc * 32 + 8 * fq;
        const float k1 = (act == 1) ? -1.5957691216057308f * LOG2E : -LOG2E, k3 = (act == 1) ? -1.5957691216057308f * 0.044715f * LOG2E : 0.f;
#pragma unroll
        for (int ai = 0; ai < 2; ++ai)
#pragma unroll
            for (int m = 0; m < 4; ++m) { bf16_t* rowp = H + (size_t)(row0 + ai * HALF + m * 16) * LDH + col0;
#pragma unroll
                for (int bj = 0; bj < 2; ++bj) { float v[8];
#pragma unroll
                    for (int j = 0; j < 4; ++j) { v[j] = acc[ai][bj][m][0][j]; v[4 + j] = acc[ai][bj][m][1][j]; }
                    if (act != 0) {
#pragma unroll
                        for (int j = 0; j < 8; j += 2) { typedef float f32x2 __attribute__((ext_vector_type(2)));
                            const f32x2 x = {v[j], v[j + 1]}; const f32x2 t = x * (x * x * k3 + k1);
                            f32x2 d = {__builtin_amdgcn_exp2f(t.x), __builtin_amdgcn_exp2f(t.y)}; d = d + 1.0f;
                            const f32x2 r = {__builtin_amdgcn_rcpf(d.x), __builtin_amdgcn_rcpf(d.y)}; const f32x2 y = x * r; v[j] = y.x; v[j + 1] = y.y; }
                    }
                    u32x4 w; w.x = cvt_pk_bf16(v[0], v[1]); w.y = cvt_pk_bf16(v[2], v[3]); w.z = cvt_pk_bf16(v[4], v[5]); w.w = cvt_pk_bf16(v[6], v[7]);
                    *(u32x4*)(rowp + bj * HALF) = w; } }
    }
};
struct EpiBf16 {
    static constexpr bool PERM = true;
    bf16_t* O; int ldc; size_t zstride; const float* bias; int zbias; int act;
    __device__ __forceinline__ void operator()(const f32x4 (&acc)[2][2][4][2], const Unit& u, int wr, int wc, int fr, int fq) const {
        const int row0 = u.pm * BM + wr * 64 + fr, col0 = u.pn * BM + wc * 32 + 8 * fq;
        bf16_t* base = O + (size_t)u.z * zstride;
#pragma unroll
        for (int ai = 0; ai < 2; ++ai)
#pragma unroll
            for (int m = 0; m < 4; ++m) { bf16_t* rowp = base + (size_t)(row0 + ai * HALF + m * 16) * ldc + col0;
#pragma unroll
                for (int bj = 0; bj < 2; ++bj) { float v[8];
#pragma unroll
                    for (int j = 0; j < 4; ++j) { v[j] = acc[ai][bj][m][0][j]; v[4 + j] = acc[ai][bj][m][1][j]; }
                    if (bias) {
#pragma unroll
                        for (int j = 0; j < 8; ++j) v[j] += bias[u.z * zbias + col0 + bj * HALF + j];
                    }
                    if (act == 2) {
#pragma unroll
                        for (int j = 0; j < 8; ++j) v[j] = siluf_(v[j]);
                    }
                    u32x4 w; w.x = cvt_pk_bf16(v[0], v[1]); w.y = cvt_pk_bf16(v[2], v[3]); w.z = cvt_pk_bf16(v[4], v[5]); w.w = cvt_pk_bf16(v[6], v[7]);
                    *(u32x4*)(rowp + bj * HALF) = w; } }
    }
};
struct EpiMerge {
    static constexpr bool PERM = true;
    bf16_t* Mg; const unsigned char* G8;
    __device__ __forceinline__ void operator()(const f32x4 (&acc)[2][2][4][2], const Unit& u, int wr, int wc, int fr, int fq) const {
        const int row0 = u.pm * BM + wr * 64 + fr, col0 = u.pn * BM + wc * 32 + 8 * fq;
        u32x2 g[2][4][2];
#pragma unroll
        for (int ai = 0; ai < 2; ++ai)
#pragma unroll
            for (int m = 0; m < 4; ++m) { const unsigned char* gp = G8 + (size_t)(row0 + ai * HALF + m * 16) * 8192 + u.z * DM + col0;
#pragma unroll
                for (int bj = 0; bj < 2; ++bj) g[ai][m][bj] = *(const u32x2*)(gp + bj * HALF); }
#pragma unroll
        for (int ai = 0; ai < 2; ++ai) {
            u32x4 p[4][2];
#pragma unroll
            for (int m = 0; m < 4; ++m)
#pragma unroll
                for (int bj = 0; bj < 2; ++bj) { p[m][bj] = (u32x4){0u, 0u, 0u, 0u}; if (u.z > 0) p[m][bj] = *(const u32x4*)(Mg + (size_t)(row0 + ai * HALF + m * 16) * DM + col0 + bj * HALF); }
#pragma unroll
            for (int m = 0; m < 4; ++m) { bf16_t* mp = Mg + (size_t)(row0 + ai * HALF + m * 16) * DM + col0;
#pragma unroll
                for (int bj = 0; bj < 2; ++bj) { const u32x2 gg = g[ai][m][bj]; const u32x4 pp = p[m][bj];
                    const f32x4 a0 = acc[ai][bj][m][0] * (1.0f / 255.0f), a1 = acc[ai][bj][m][1] * (1.0f / 255.0f);
                    const float v0 = (float)(gg.x & 255u) * a0[0] + bflo(pp.x), v1 = (float)((gg.x >> 8) & 255u) * a0[1] + bfhi(pp.x), v2 = (float)((gg.x >> 16) & 255u) * a0[2] + bflo(pp.y), v3 = (float)(gg.x >> 24) * a0[3] + bfhi(pp.y);
                    const float v4 = (float)(gg.y & 255u) * a1[0] + bflo(pp.z), v5 = (float)((gg.y >> 8) & 255u) * a1[1] + bfhi(pp.z), v6 = (float)((gg.y >> 16) & 255u) * a1[2] + bflo(pp.w), v7 = (float)(gg.y >> 24) * a1[3] + bfhi(pp.w);
                    u32x4 w; w.x = cvt_pk_bf16(v0, v1); w.y = cvt_pk_bf16(v2, v3); w.z = cvt_pk_bf16(v4, v5); w.w = cvt_pk_bf16(v6, v7);
                    *(u32x4*)(mp + bj * HALF) = w; } } }
    }
};
struct EpiOutLN {
    static constexpr bool PERM = false;
    const float* xres; float* out; bf16_t* xb; const float* lg; const float* lb; unsigned* cnt; unsigned long long* slots; LAS unsigned char* lx;
    __device__ __forceinline__ void operator()(f32x4 (&acc)[2][2][4][2], const Unit& u, int wr, int wc, int fr, int fq) const {
        typedef float f32x2v __attribute__((ext_vector_type(2)));
        LAS f32x2v* Pt = (LAS f32x2v*)lx;
        LAS f32x2v* St = (LAS f32x2v*)(lx + 8192);
        const int tid = opaque_tid(), wid = tid >> 6, lane = tid & 63;
        const int row0 = u.pm * BM + wr * 64 + fr, col0 = u.pn * BM + wc * 32 + 4 * fq;
#pragma unroll
        for (int ai = 0; ai < 2; ++ai)
#pragma unroll
            for (int m = 0; m < 4; ++m) { const size_t off = (size_t)(row0 + ai * HALF + m * 16) * DM + col0; float sm = 0.f;
#pragma unroll
                for (int bj = 0; bj < 2; ++bj)
#pragma unroll
                    for (int n = 0; n < 2; ++n) { const f32x4 x = *(const f32x4*)(xres + off + bj * HALF + n * 16); const f32x4 z = x * 1.4142135623730951f + acc[ai][bj][m][n];
                        acc[ai][bj][m][n] = z; sm += (z[0] + z[1]) + (z[2] + z[3]); }
                sm += __shfl_xor(sm, 16); sm += __shfl_xor(sm, 32);
                const float mw = sm * (1.0f / 64.0f); float q = 0.f;
#pragma unroll
                for (int bj = 0; bj < 2; ++bj)
#pragma unroll
                    for (int n = 0; n < 2; ++n) { const f32x4 d = acc[ai][bj][m][n] - mw; q += (d[0] * d[0] + d[1] * d[1]) + (d[2] * d[2] + d[3] * d[3]); }
                q += __shfl_xor(q, 16); q += __shfl_xor(q, 32);
                if (fq == 0) Pt[(ai * HALF + wr * 64 + m * 16 + fr) * 4 + wc] = (f32x2v){mw, q}; }
        __syncthreads();
        const int row = wid * 32 + (lane & 31);
        if (lane < 32) { const f32x2v a = Pt[row * 4 + 0], b = Pt[row * 4 + 1], c = Pt[row * 4 + 2], d = Pt[row * 4 + 3];
            const float mt = (a.x + b.x + c.x + d.x) * 0.25f; const float da = a.x - mt, db = b.x - mt, dc = c.x - mt, dd = d.x - mt;
            const float m2 = (a.y + b.y) + (c.y + d.y) + 64.0f * ((da * da + db * db) + (dc * dc + dd * dd));
            __hip_atomic_store(slots + ((size_t)(u.pm * BM + row) * 8 + u.pn), ((unsigned long long)__float_as_uint(m2) << 32) | __float_as_uint(mt), __ATOMIC_RELAXED, __HIP_MEMORY_SCOPE_AGENT); }
        asm volatile("s_waitcnt vmcnt(0)" ::: "memory");
        if (lane == 0) __hip_atomic_fetch_add(cnt + u.pm, 1u, __ATOMIC_RELAXED, __HIP_MEMORY_SCOPE_AGENT);
        if (wid == 0) { unsigned polls = 0;
            while ((unsigned)__builtin_amdgcn_readfirstlane(__hip_atomic_load(cnt + u.pm, __ATOMIC_RELAXED, __HIP_MEMORY_SCOPE_AGENT)) < 64u) { if (++polls > (1u << 22)) break; __builtin_amdgcn_s_sleep(2); }
            __builtin_amdgcn_fence(__ATOMIC_ACQUIRE, "agent"); }
        asm volatile("s_waitcnt vmcnt(0) lgkmcnt(0)" ::: "memory");
        __syncthreads();
        if (lane < 32) { const unsigned long long* sl = slots + (size_t)(u.pm * BM + row) * 8; float mt[8], m2[8]; float ms = 0.f;
#pragma unroll
            for (int t = 0; t < 8; ++t) { const unsigned long long w = __hip_atomic_load(sl + t, __ATOMIC_RELAXED, __HIP_MEMORY_SCOPE_AGENT); mt[t] = __uint_as_float((unsigned)w); m2[t] = __uint_as_float((unsigned)(w >> 32)); ms += mt[t]; }
            const float mean = ms * 0.125f; float q = 0.f;
#pragma unroll
            for (int t = 0; t < 8; ++t) { const float dm = mt[t] - mean; q += m2[t] + 256.0f * dm * dm; }
            St[row] = (f32x2v){mean, rsqrtf(q * (1.0f / 2048.0f) + 1e-5f)}; }
        __syncthreads();
#pragma unroll
        for (int ai = 0; ai < 2; ++ai)
#pragma unroll
            for (int m = 0; m < 4; ++m) { const int rl = ai * HALF + wr * 64 + m * 16 + fr; const f32x2v sr = St[rl]; const size_t off = (size_t)(u.pm * BM + rl) * DM + col0;
#pragma unroll
                for (int bj = 0; bj < 2; ++bj)
#pragma unroll
                    for (int n = 0; n < 2; ++n) { const int co = bj * HALF + n * 16; const f32x4 gg = *(const f32x4*)(lg + col0 + co), bb = *(const f32x4*)(lb + col0 + co);
                        const f32x4 y = (acc[ai][bj][m][n] - sr.x) * sr.y * gg + bb; *(f32x4*)(out + off + co) = y;
                        if (xb) { u32x2 w; w.x = cvt_pk_bf16(y[0], y[1]); w.y = cvt_pk_bf16(y[2], y[3]); *(u32x2*)(xb + off + co) = w; } } }
        __syncthreads();
    }
};
}

__device__ __forceinline__ void tconv_tile(LAS float* tile, const float* src, int ld, int k0, int n0, int mode, bf16_t* dst, int K) {
    const int tid = opaque_tid();
#pragma unroll
    for (int it = 0; it < 2; ++it) { const int idx = tid + it * 512, kk = idx >> 4, n4 = (idx & 15) * 4, nn = n0 + n4; int oc = nn; bool valid = true;
        if (mode == 1) { if (nn < 7680) oc = nn; else if (nn < 18944) oc = nn + 48; else if (nn < INW) oc = 7680 + (nn - 18944); else valid = false; }
        f32x4 v = (f32x4){0.f, 0.f, 0.f, 0.f}; if (valid) v = *(const f32x4*)(src + (size_t)(k0 + kk) * ld + oc);
        tile[kk * 65 + n4 + 0] = v[0]; tile[kk * 65 + n4 + 1] = v[1]; tile[kk * 65 + n4 + 2] = v[2]; tile[kk * 65 + n4 + 3] = v[3]; }
    __syncthreads();
    { const int n = tid >> 3, k8 = (tid & 7) * 8; float v[8];
#pragma unroll
        for (int e = 0; e < 8; ++e) v[e] = tile[(k8 + e) * 65 + n];
        u32x4 w; w.x = cvt_pk_bf16(v[0], v[1]); w.y = cvt_pk_bf16(v[2], v[3]); w.z = cvt_pk_bf16(v[4], v[5]); w.w = cvt_pk_bf16(v[6], v[7]);
        *(u32x4*)(dst + (size_t)(n0 + n) * K + k0 + k8) = w; }
    __syncthreads();
}

__device__ __forceinline__ void prologue(LAS unsigned char* lds, const Ctx& P, int l) {
    unsigned char* ws = P.ws; LAS float* tile = (LAS float*)lds;
    const int tid = opaque_tid(), G = gridDim.x;
    const int T_IN = 32 * 300, T_BR = 4 * 512, T_OUT = 1024, T_MEM = 1024, T_W1 = 256, T_WA = 64;
    const int T_ALL = T_IN + T_BR + T_OUT + T_MEM + T_W1 + T_WA;
    for (int t = blockIdx.x; t < T_ALL; t += G) {
        int q = t;
        if (q < T_IN) { const int kt = q & 31, ntl = q >> 5; tconv_tile(tile, P.in[3] + (size_t)l * DM * INW, INW, kt * 64, ntl * 64, 1, (bf16_t*)(ws + WS_WIN), DM); continue; }
        q -= T_IN;
        if (q < T_BR) { const int br = q >> 9, r = q & 511, kt = r & 15, ntl = r >> 4;
            tconv_tile(tile, P.in[23] + ((size_t)l * 4 + br) * DBR * DM, DM, kt * 64, ntl * 64, 0, (bf16_t*)(ws + WS_WBR) + (size_t)br * DM * DBR, DBR); continue; }
        q -= T_BR;
        if (q < T_OUT) { const int kt = q & 31, ntl = q >> 5; tconv_tile(tile, P.in[24] + (size_t)l * DM * DM, DM, kt * 64, ntl * 64, 0, (bf16_t*)(ws + WS_WOUT), DM); continue; }
        q -= T_OUT;
        if (q < T_MEM) { const int kt = q & 31, ntl = q >> 5; tconv_tile(tile, P.in[22] + (size_t)l * DM * DM, DM, kt * 64, ntl * 64, 0, (bf16_t*)(ws + WS_WMEM), DM); continue; }
        q -= T_MEM;
        if (q < T_W1) { const int kv = q >> 7, r = q & 127, kt = r & 31, ntl = r >> 5;
            tconv_tile(tile, P.in[17 + kv] + (size_t)l * 2048 * 256, 256, kt * 64, ntl * 64, 0, (bf16_t*)(ws + WS_W1T) + (size_t)kv * 256 * 2048, 2048); continue; }
        q -= T_W1;
        { const int mat = q >> 5, r = q & 31, n = r >> 2, kt = r & 1, ntl = (r >> 1) & 1;
            tconv_tile(tile, P.in[mat ? 12 : 10] + ((size_t)l * 8 + n) * 128 * 128, 128, kt * 64, ntl * 64, 0, (bf16_t*)(ws + WS_WAT) + ((size_t)mat * 8 + n) * 128 * 128, 128); }
    }
    const size_t gtid = (size_t)blockIdx.x * 512 + tid, gstride = (size_t)G * 512;
    { const float* sw = P.in[6] + (size_t)l * 8 * 128 * 128; bf16_t* d = (bf16_t*)(ws + WS_SGW);
        for (size_t i = gtid; i < (size_t)8 * 128 * 128 / 2; i += gstride) { const size_t e = i * 2; const int s = (int)(e & 127), t = (int)((e >> 7) & 127);
            const float a = (s <= t) ? sw[e] : 0.f, b = (s + 1 <= t) ? sw[e + 1] : 0.f; ((unsigned*)d)[i] = cvt_pk_bf16(a, b); } }
    for (int u = blockIdx.x; u < 8; u += G) { const int kv = u >> 2, cb = u & 3, col = cb * 64 + (tid & 63), ks = tid >> 6;
        const float* pe = P.in[15 + kv] + (size_t)l * 2048; const float* w1 = P.in[17 + kv] + (size_t)l * 2048 * 256; float s = 0.f;
        for (int k = ks * 256; k < ks * 256 + 256; ++k) s += pe[k] * w1[(size_t)k * 256 + col];
        tile[tid] = s; __syncthreads();
        if (tid < 64) { float a = 0.f;
#pragma unroll
            for (int j = 0; j < 8; ++j) a += tile[j * 64 + tid];
            ((float*)(ws + WS_PEW1))[kv * 256 + col] = a; }
        __syncthreads(); }
    { const float* lam = P.in[14] + (size_t)l * DBR; float* sp8 = (float*)(ws + WS_PEW1) + 512;
        for (size_t i = gtid; i < (size_t)DBR; i += gstride) sp8[i] = 8.0f * log1pf(expf(-lam[i])); }
    if (l == 0) {
        { const f32x4* x = (const f32x4*)P.in[0]; u32x2* d = (u32x2*)(ws + WS_XB);
            for (size_t i = gtid; i < (size_t)MT * DM / 4; i += 4 * gstride) { f32x4 v[4];
#pragma unroll
                for (int k = 0; k < 4; ++k) { const size_t j = i + k * gstride; v[k] = (j < (size_t)MT * DM / 4) ? x[j] : (f32x4){0.f, 0.f, 0.f, 0.f}; }
#pragma unroll
                for (int k = 0; k < 4; ++k) { const size_t j = i + k * gstride; if (j < (size_t)MT * DM / 4) { u32x2 w; w.x = cvt_pk_bf16(v[k][0], v[k][1]); w.y = cvt_pk_bf16(v[k][2], v[k][3]); d[j] = w; } } } }
        { const f32x4* x = (const f32x4*)P.in[1]; u32x2* d = (u32x2*)(ws + WS_MEMB);
            for (size_t i = gtid; i < (size_t)1024 * DM / 4; i += gstride) { const f32x4 v = x[i]; u32x2 w; w.x = cvt_pk_bf16(v[0], v[1]); w.y = cvt_pk_bf16(v[2], v[3]); d[i] = w; } }
        { float* lut = (float*)(ws + WS_LUT); const float* rb = P.in[2];
            for (size_t i = gtid; i < (size_t)16 * 4096; i += gstride) { const int h = (int)(i >> 12), dist = (int)(i & 4095); lut[i] = rb[rel_bucket(dist) * 16 + h] * LOG2E; } }
    }
}

template <int D, class SF>
__device__ __forceinline__ void attn_step(const bf16x8 (&qf)[D / 32], const LAS bf16_t* Ks, const LAS bf16_t* Vt, f32x4 (&o)[D / 16], float& m, float& lsum, float& alpha_out, bf16x8& pf0_out, bf16x8& pf1_out, const int lane, SF sf) {
    constexpr int KSTR = D + 8;
    const int c = lane & 15, i = lane >> 4;
    f32x4 s[4];
#pragma unroll
    for (int t = 0; t < 4; ++t) s[t] = (f32x4){0.f, 0.f, 0.f, 0.f};
#pragma unroll
    for (int ks = 0; ks < D / 32; ++ks) {
#pragma unroll
        for (int t = 0; t < 4; ++t) { const bf16x8 kf = *(const LAS bf16x8*)(Ks + (16 * t + c) * KSTR + ks * 32 + 8 * i); s[t] = mfma16(kf, qf[ks], s[t]); }
    }
    float v[16];
#pragma unroll
    for (int t = 0; t < 4; ++t)
#pragma unroll
        for (int r = 0; r < 4; ++r) v[4 * t + r] = sf(16 * t + 4 * i + r, s[t][r]);
    float mx = fmaxf(fmaxf(fmaxf(v[0], v[1]), fmaxf(v[2], v[3])), fmaxf(fmaxf(v[4], v[5]), fmaxf(v[6], v[7])));
    mx = fmaxf(mx, fmaxf(fmaxf(fmaxf(v[8], v[9]), fmaxf(v[10], v[11])), fmaxf(fmaxf(v[12], v[13]), fmaxf(v[14], v[15]))));
    mx = fmaxf(mx, __shfl_xor(mx, 16)); mx = fmaxf(mx, __shfl_xor(mx, 32));
    const float mnew = fmaxf(m, mx);
    const float mc = fmaxf(mnew, -1e20f);
    const float alpha = __builtin_amdgcn_exp2f(fmaxf(m, -1e20f) - mc);
    float p[16], rs = 0.f;
#pragma unroll
    for (int r = 0; r < 16; ++r) { p[r] = __builtin_amdgcn_exp2f(v[r] - mc); rs += p[r]; }
    rs += __shfl_xor(rs, 16); rs += __shfl_xor(rs, 32);
    lsum = lsum * alpha + rs; m = mnew;
    union { u32x4 u; bf16x8 b; } pk0, pk1;
    pk0.u.x = cvt_pk_bf16(p[0], p[1]); pk0.u.y = cvt_pk_bf16(p[2], p[3]); pk0.u.z = cvt_pk_bf16(p[4], p[5]); pk0.u.w = cvt_pk_bf16(p[6], p[7]);
    pk1.u.x = cvt_pk_bf16(p[8], p[9]); pk1.u.y = cvt_pk_bf16(p[10], p[11]); pk1.u.z = cvt_pk_bf16(p[12], p[13]); pk1.u.w = cvt_pk_bf16(p[14], p[15]);
    if (__builtin_amdgcn_ballot_w64(alpha != 1.0f) != 0ull) {
#pragma unroll
        for (int dt = 0; dt < D / 16; ++dt) o[dt] *= alpha;
    }
#pragma unroll
    for (int dt = 0; dt < D / 16; ++dt) {
        const LAS bf16_t* vp = Vt + (16 * dt + c) * 72 + 4 * i;
        union { u32x4 u; bf16x8 b; } vf0, vf1; const u32x2 a0 = *(const LAS u32x2*)vp, a1 = *(const LAS u32x2*)(vp + 16), b0 = *(const LAS u32x2*)(vp + 32), b1 = *(const LAS u32x2*)(vp + 48);
        vf0.u.x = a0.x; vf0.u.y = a0.y; vf0.u.z = a1.x; vf0.u.w = a1.y; vf1.u.x = b0.x; vf1.u.y = b0.y; vf1.u.z = b1.x; vf1.u.w = b1.y;
        o[dt] = mfma16(vf0.b, pk0.b, o[dt]); o[dt] = mfma16(vf1.b, pk1.b, o[dt]);
    }
    alpha_out = alpha; pf0_out = pk0.b; pf1_out = pk1.b;
}
template <int D>
__device__ __forceinline__ void load_k_tile(const int tid, LAS bf16_t* Ks, const bf16_t* src, size_t ld, int p0, int pmax) {
#pragma unroll
    for (int it = 0; it < D / 64; ++it) { const int idx = tid + it * 512, key = idx & 63, seg = idx >> 6, p = p0 + key;
        u32x4 v = (u32x4){0u, 0u, 0u, 0u}; if (p >= 0 && p <= pmax) v = *(const u32x4*)(src + (size_t)p * ld + seg * 8);
        *(LAS u32x4*)(Ks + key * (D + 8) + seg * 8) = v; }
}
template <int D>
__device__ __forceinline__ void load_vt_tile(const int tid, LAS bf16_t* Vt, const bf16_t* src, size_t ld, int p0, int pmax) {
#pragma unroll
    for (int it = 0; it < D / 64; ++it) { const int idx = tid + it * 512, key = idx & 63, seg = idx >> 6, p = p0 + key;
        u32x4 v = (u32x4){0u, 0u, 0u, 0u}; if (p >= 0 && p <= pmax) v = *(const u32x4*)(src + (size_t)p * ld + seg * 8);
        LAS bf16_t* d = Vt + (seg * 8) * 72 + key;
        d[0 * 72] = (bf16_t)(v.x & 0xffffu); d[1 * 72] = (bf16_t)(v.x >> 16); d[2 * 72] = (bf16_t)(v.y & 0xffffu); d[3 * 72] = (bf16_t)(v.y >> 16);
        d[4 * 72] = (bf16_t)(v.z & 0xffffu); d[5 * 72] = (bf16_t)(v.z >> 16); d[6 * 72] = (bf16_t)(v.w & 0xffffu); d[7 * 72] = (bf16_t)(v.w >> 16); }
}
__device__ __forceinline__ bf16x8 load_q_scaled(const bf16_t* p, float scale) {
    const u32x4 r = *(const u32x4*)p; union { u32x4 u; bf16x8 b; } q;
    q.u.x = cvt_pk_bf16(bflo(r.x) * scale, bfhi(r.x) * scale); q.u.y = cvt_pk_bf16(bflo(r.y) * scale, bfhi(r.y) * scale);
    q.u.z = cvt_pk_bf16(bflo(r.z) * scale, bfhi(r.z) * scale); q.u.w = cvt_pk_bf16(bflo(r.w) * scale, bfhi(r.w) * scale); return q.b;
}

__device__ __forceinline__ void memattn_unit(LAS unsigned char* lds, const Ctx& P, int unit) {
    const bf16_t* H = (const bf16_t*)(P.ws + WS_H); const bf16_t* MKV = (const bf16_t*)(P.ws + WS_MKV); bf16_t* O = (bf16_t*)(P.ws + WS_O) + (size_t)3 * MT * DBR;
    LAS bf16_t* Ks = (LAS bf16_t*)lds; LAS bf16_t* Vt = (LAS bf16_t*)(lds + 64 * 264 * 2);
    const int tb = unit & 31, head = (unit >> 5) & 3, b = unit >> 7;
    const int tid = opaque_tid(), wid = tid >> 6, lane = tid & 63, c = lane & 15, i = lane >> 4;
    const size_t tok = (size_t)b * SEQ + tb * 128 + wid * 16 + c;
    bf16x8 qf[8];
#pragma unroll
    for (int ks = 0; ks < 8; ++ks) qf[ks] = load_q_scaled(H + tok * LDH + C_QM + head * 256 + ks * 32 + 8 * i, 0.0625f);
    f32x4 o[16];
#pragma unroll
    for (int dt = 0; dt < 16; ++dt) o[dt] = (f32x4){0.f, 0.f, 0.f, 0.f};
    float m = NEGBIG, lsum = 0.f, alpha; bf16x8 pf, pf1;
    const bf16_t* kb = MKV + (size_t)b * 256 * DM + head * 256; const bf16_t* vb = kb + 1024;
    for (int kt = 0; kt < 4; ++kt) {
        __syncthreads();
        { u32x4 kr[4], vr[4];
#pragma unroll
            for (int it = 0; it < 4; ++it) { const int idx = tid + it * 512, key = idx & 63, seg = idx >> 6; const size_t off = (size_t)(kt * 64 + key) * DM + seg * 8; kr[it] = *(const u32x4*)(kb + off); vr[it] = *(const u32x4*)(vb + off); }
#pragma unroll
            for (int it = 0; it < 4; ++it) { const int idx = tid + it * 512, key = idx & 63, seg = idx >> 6; *(LAS u32x4*)(Ks + key * 264 + seg * 8) = kr[it];
                LAS bf16_t* d = Vt + (seg * 8) * 72 + key; const u32x4 v = vr[it];
                d[0 * 72] = (bf16_t)(v.x & 0xffffu); d[1 * 72] = (bf16_t)(v.x >> 16); d[2 * 72] = (bf16_t)(v.y & 0xffffu); d[3 * 72] = (bf16_t)(v.y >> 16);
                d[4 * 72] = (bf16_t)(v.z & 0xffffu); d[5 * 72] = (bf16_t)(v.z >> 16); d[6 * 72] = (bf16_t)(v.w & 0xffffu); d[7 * 72] = (bf16_t)(v.w >> 16); } }
        __syncthreads();
        attn_step<256>(qf, Ks, Vt, o, m, lsum, alpha, pf, pf1, lane, [](int, float s) { return s * LOG2E; });
    }
    const float inv = 1.0f / fmaxf(lsum, 1e-30f);
#pragma unroll
    for (int dt = 0; dt < 16; ++dt) { const int d0 = 16 * dt + 4 * i; const u32x2 g = *(const u32x2*)(H + tok * LDH + C_GM + head * 256 + d0);
        u32x2 w; w.x = cvt_pk_bf16(o[dt][0] * inv * bflo(g.x), o[dt][1] * inv * bfhi(g.x)); w.y = cvt_pk_bf16(o[dt][2] * inv * bflo(g.y), o[dt][3] * inv * bfhi(g.y));
        *(u32x2*)(O + tok * DBR + head * 256 + d0) = w; }
}

constexpr int NSA_LUT = 0  , NSA_KV = 16384  , NSA_IMP = NSA_KV + 36864  , NSA_SEL = NSA_IMP + 65536;
struct TileRegs { u32x4 k, v; };
__device__ __forceinline__ void tile_issue(TileRegs& r, const int tid, const bf16_t* ksrc, const bf16_t* vsrc, size_t ld, int p0, int pmax) {
    const int kkey = tid >> 3, kseg = tid & 7, pk = p0 + kkey; const int vkey = tid & 63, vseg = tid >> 6, pv = p0 + vkey;
    r.k = (u32x4){0u, 0u, 0u, 0u}; r.v = (u32x4){0u, 0u, 0u, 0u};
    if (pk >= 0 && pk <= pmax) r.k = *(const u32x4*)(ksrc + (size_t)pk * ld + kseg * 8);
    if (pv >= 0 && pv <= pmax) r.v = *(const u32x4*)(vsrc + (size_t)pv * ld + vseg * 8); }
__device__ __forceinline__ void tile_commit(const TileRegs& r, const int tid, LAS bf16_t* Ks, LAS bf16_t* Vt) {
    { const int key = tid >> 3, seg = tid & 7; *(LAS u32x4*)(Ks + key * 72 + seg * 8) = r.k; }
    const int key = tid & 63, seg = tid >> 6;
    LAS bf16_t* d = Vt + (seg * 8) * 72 + key; const u32x4 v = r.v;
    d[0 * 72] = (bf16_t)(v.x & 0xffffu); d[1 * 72] = (bf16_t)(v.x >> 16); d[2 * 72] = (bf16_t)(v.y & 0xffffu); d[3 * 72] = (bf16_t)(v.y >> 16);
    d[4 * 72] = (bf16_t)(v.z & 0xffffu); d[5 * 72] = (bf16_t)(v.z >> 16); d[6 * 72] = (bf16_t)(v.w & 0xffffu); d[7 * 72] = (bf16_t)(v.w >> 16); }
__device__ __forceinline__ void nsa_unit(LAS unsigned char* lds, const Ctx& P, int l, int b, int hkv, int tb) {
    const bf16_t* H = (const bf16_t*)(P.ws + WS_H); bf16_t* O = (bf16_t*)(P.ws + WS_O) + (size_t)2 * MT * DBR;
    const bf16_t* KC = (const bf16_t*)(P.ws + WS_KCV) + (size_t)((b * 4 + hkv) * 256) * 64; const bf16_t* VC = KC + (size_t)4096 * 64;
    LAS bf16_t* KV = (LAS bf16_t*)(lds + NSA_KV);
    LAS float* impb = (LAS float*)(lds + NSA_IMP); LAS unsigned long long* sels = (LAS unsigned long long*)(lds + NSA_SEL);
    const int tid = opaque_tid(), wid = tid >> 6, lane = tid & 63, c = lane & 15, i = lane >> 4, g = wid & 3, th = wid >> 2, hq = hkv * 4 + g;
    const LAS float* lut = (const LAS float*)(lds + NSA_LUT) + g * 1024;
    const int t0 = tb * 64, qb = tb;
    int tq[2]; size_t tok[2];
#pragma unroll
    for (int sb = 0; sb < 2; ++sb) { tq[sb] = t0 + 32 * th + 16 * sb + c; tok[sb] = (size_t)b * SEQ + tq[sb]; }
    bf16x8 qf[2][2];
#pragma unroll
    for (int sb = 0; sb < 2; ++sb)
#pragma unroll
        for (int ks = 0; ks < 2; ++ks) qf[sb][ks] = load_q_scaled(H + tok[sb] * LDH + C_Q + hq * 64 + ks * 32 + 8 * i, 0.125f);
    f32x4* park = (f32x4*)(P.ws + WS_PARK) + ((size_t)(blockIdx.x * 8 + wid) * 8) * 64 + lane;
    float alpha; bf16x8 pf, pf1;
    auto load2 = [&](const bf16_t* ksrc, const bf16_t* vsrc, size_t ld, int p0a, int p0b, bool hasb, int pmax) {
        TileRegs ra, rb; tile_issue(ra, tid, ksrc, vsrc, ld, p0a, pmax); if (hasb) tile_issue(rb, tid, ksrc, vsrc, ld, p0b, pmax);
        tile_commit(ra, tid, KV, KV + 4608); if (hasb) tile_commit(rb, tid, KV + 9216, KV + 9216 + 4608); };
#pragma unroll 1
    for (int sb = 0; sb < 2; ++sb) {
        f32x4 o[4], oi[4]; float m = NEGBIG, lsum = 0.f;
#pragma unroll
        for (int dt = 0; dt < 4; ++dt) { o[dt] = (f32x4){0.f, 0.f, 0.f, 0.f}; oi[dt] = (f32x4){0.f, 0.f, 0.f, 0.f}; }
        bf16x8 ovA[2], ovB[2];
#pragma unroll
        for (int st = 0; st < 2; ++st)
#pragma unroll
            for (int j = 0; j < 8; ++j) { const int nl = 32 * st + (j < 4 ? 4 * i + j : 16 + 4 * i + (j - 4));
                float a = 0.f; if ((nl >> 2) == c) a = ((nl & 3) == 3) ? 0.5f : 1.0f; else if ((nl >> 2) == c - 1 && (nl & 3) == 3) a = 0.5f;
                const float bb = (c == 0 && nl == 63) ? 0.5f : 0.f;
                ovA[st][j] = (short)(__float_as_uint(a) >> 16); ovB[st][j] = (short)(__float_as_uint(bb) >> 16); }
        const int ntile = ((t0 >> 4) + 2) / 64 + 1;
        const int tqs = t0 + 32 * th + 16 * sb + c;
        bf16x8 qs[2];
#pragma unroll
        for (int ks = 0; ks < 2; ++ks) qs[ks] = load_q_scaled(H + ((size_t)b * SEQ + tqs) * LDH + C_Q + hq * 64 + ks * 32 + 8 * i, 0.125f);
#pragma unroll
        for (int pr = 0; pr < 2; ++pr) if (2 * pr < ntile) {
            const bool hasb = 2 * pr + 1 < ntile;
            __syncthreads();
            load2(KC, VC, 64, 128 * pr, 128 * pr + 64, hasb, 255);
            __syncthreads();
#pragma unroll
            for (int sl = 0; sl < 2; ++sl) if (sl == 0 || hasb) {
                const int kt = 2 * pr + sl; const LAS bf16_t* Ks = KV + sl * 9216; const LAS bf16_t* Vt = Ks + 4608; const int nb = kt * 64;
                attn_step<64>(qs, Ks, Vt, o, m, lsum, alpha, pf, pf1, lane,
                    [&](int kk, float s) { const int dist = tqs - (16 * (nb + kk) + 31); return dist >= 0 ? s * LOG2E + lut[min((unsigned)dist, 1023u)] : NEGBIG; });
#pragma unroll
                for (int jt = 0; jt < 4; ++jt) oi[jt] *= alpha;
                oi[kt] = mfma16(ovA[0], pf, oi[kt]); oi[kt] = mfma16(ovA[1], pf1, oi[kt]);
                if (kt + 1 < 4) { oi[kt + 1 < 4 ? kt + 1 : 3] = mfma16(ovB[0], pf, oi[kt + 1 < 4 ? kt + 1 : 3]); oi[kt + 1 < 4 ? kt + 1 : 3] = mfma16(ovB[1], pf1, oi[kt + 1 < 4 ? kt + 1 : 3]); }
            }
        }
        const float inv = 1.0f / fmaxf(lsum, 1e-30f);
        const float g0 = sigmoidf_(bf2f(H[((size_t)b * SEQ + tqs) * LDH + C_GL + hq]) + P.in[21][l * 48 + hq]) * inv;
#pragma unroll
        for (int dt = 0; dt < 4; ++dt) { park[(sb * 4 + dt) * 64] = o[dt] * g0;
            *(LAS f32x4*)(impb + (g * 64 + 32 * th + 16 * sb + c) * 64 + 16 * dt + 4 * i) = oi[dt] * inv; }
    }
    __syncthreads();
    {
#pragma unroll
        for (int tt = 0; tt < 8; ++tt) { const int tl = 8 * wid + tt;
            unsigned long long mask;
            if (qb <= 7) mask = (2ull << qb) - 1ull;
            else {
                const float v = impb[(0 * 64 + tl) * 64 + lane] + impb[(1 * 64 + tl) * 64 + lane] + impb[(2 * 64 + tl) * 64 + lane] + impb[(3 * 64 + tl) * 64 + lane];
                float vv = (lane >= 1 && lane <= qb - 2) ? v : -__builtin_inff();
                mask = 1ull | (1ull << qb) | (1ull << (qb - 1));
#pragma unroll
                for (int r = 0; r < 5; ++r) { const float mx = wave_max(vv); const unsigned long long bal = __ballot(vv == mx);
                    const int js = __builtin_ctzll(bal); mask |= 1ull << js; if (lane == js) vv = -__builtin_inff(); }
            }
            if (lane == 0) sels[tl] = mask; }
    }
    __syncthreads();
    {
        unsigned long long ms[2]; unsigned long long U = 0ull;
#pragma unroll
        for (int sb = 0; sb < 2; ++sb) ms[sb] = sels[32 * th + 16 * sb + c];
        for (int t = 0; t < 64; ++t) U |= sels[t];
        f32x4 o[2][4]; float m[2], lsum[2];
#pragma unroll
        for (int sb = 0; sb < 2; ++sb) { m[sb] = NEGBIG; lsum[sb] = 0.f;
#pragma unroll
            for (int dt = 0; dt < 4; ++dt) o[sb][dt] = (f32x4){0.f, 0.f, 0.f, 0.f}; }
        const bf16_t* kb = H + (size_t)b * SEQ * LDH + C_KS + hkv * 64; const bf16_t* vb = H + (size_t)b * SEQ * LDH + C_VS + hkv * 64;
        U &= ((2ull << qb) - 1ull);
        unsigned long long Ur = ((unsigned long long)(unsigned)__builtin_amdgcn_readfirstlane((int)(U >> 32)) << 32) | (unsigned)__builtin_amdgcn_readfirstlane((int)U);
        const float cfar = lut[790];
        while (Ur != 0ull) {
            const int ja = __builtin_ctzll(Ur); Ur &= Ur - 1ull; const bool hasb = Ur != 0ull; int jb = 0; if (hasb) { jb = __builtin_ctzll(Ur); Ur &= Ur - 1ull; }
            __syncthreads();
            load2(kb, vb, LDH, ja * 64, jb * 64, hasb, SEQ - 1);
            __syncthreads();
#pragma unroll
            for (int sl = 0; sl < 2; ++sl) if (sl == 0 || hasb) {
                const int j = sl ? jb : ja; const LAS bf16_t* Ks = KV + sl * 9216; const LAS bf16_t* Vt = Ks + 4608;
                const bool far = t0 - (64 * j + 63) >= 790;
#pragma unroll
                for (int sb = 0; sb < 2; ++sb) { const bool selj = (ms[sb] >> j) & 1ull; const int tqs = tq[sb];
                    if (far) {
                        if (__builtin_amdgcn_ballot_w64(selj) == 0ull) continue;
                        attn_step<64>(qf[sb], Ks, Vt, o[sb], m[sb], lsum[sb], alpha, pf, pf1, lane,
                            [&](int, float s) { return selj ? s * LOG2E + cfar : NEGBIG; });
                    } else { const int kp0 = j * 64;
                        attn_step<64>(qf[sb], Ks, Vt, o[sb], m[sb], lsum[sb], alpha, pf, pf1, lane,
                            [&](int kk, float s) { const int dist = tqs - (kp0 + kk); return (selj && dist >= 0) ? s * LOG2E + lut[min((unsigned)dist, 1023u)] : NEGBIG; });
                    }
                }
            }
        }
#pragma unroll
        for (int sb = 0; sb < 2; ++sb) { const float g1 = sigmoidf_(bf2f(H[tok[sb] * LDH + C_GL + 16 + hq]) + P.in[21][l * 48 + 16 + hq]) / fmaxf(lsum[sb], 1e-30f);
#pragma unroll
            for (int dt = 0; dt < 4; ++dt) park[(sb * 4 + dt) * 64] += o[sb][dt] * g1; }
    }
    {
        f32x4 o[2][4]; float m[2], lsum[2];
#pragma unroll
        for (int sb = 0; sb < 2; ++sb) { m[sb] = NEGBIG; lsum[sb] = 0.f;
#pragma unroll
            for (int dt = 0; dt < 4; ++dt) o[sb][dt] = (f32x4){0.f, 0.f, 0.f, 0.f}; }
        const bf16_t* kb = H + (size_t)b * SEQ * LDH + C_KW + hkv * 64; const bf16_t* vb = H + (size_t)b * SEQ * LDH + C_VW + hkv * 64;
        const int kfirst = (t0 >= 256) ? 0 : (256 - t0) / 64;
        for (int k = kfirst; k < 5; k += 2) { const int p0 = t0 - 256 + 64 * k; const bool hasb = k + 1 < 5;
            __syncthreads();
            load2(kb, vb, LDH, p0, p0 + 64, hasb, SEQ - 1);
            __syncthreads();
#pragma unroll
            for (int sl = 0; sl < 2; ++sl) if (sl == 0 || hasb) { const LAS bf16_t* Ks = KV + sl * 9216; const LAS bf16_t* Vt = Ks + 4608; const int kp0 = p0 + sl * 64;
#pragma unroll
                for (int sb = 0; sb < 2; ++sb) { const int tqs = tq[sb];
                    attn_step<64>(qf[sb], Ks, Vt, o[sb], m[sb], lsum[sb], alpha, pf, pf1, lane,
                        [&](int kk, float s) { const int kpos = kp0 + kk, dist = tqs - kpos; return (dist >= 0 && dist < 256 && kpos >= 0) ? s * LOG2E + lut[min((unsigned)dist, 1023u)] : NEGBIG; }); }
            }
        }
#pragma unroll
        for (int sb = 0; sb < 2; ++sb) { const float g2 = sigmoidf_(bf2f(H[tok[sb] * LDH + C_GL + 32 + hq]) + P.in[21][l * 48 + 32 + hq]) / fmaxf(lsum[sb], 1e-30f);
#pragma unroll
            for (int dt = 0; dt < 4; ++dt) { const f32x4 r = park[(sb * 4 + dt) * 64] + o[sb][dt] * g2;
                const int d0 = 16 * dt + 4 * i; const u32x2 gg = *(const u32x2*)(H + tok[sb] * LDH + C_GC + hq * 64 + d0);
                u32x2 w; w.x = cvt_pk_bf16(r[0] * bflo(gg.x), r[1] * bfhi(gg.x)); w.y = cvt_pk_bf16(r[2] * bflo(gg.y), r[3] * bfhi(gg.y));
                *(u32x2*)(O + tok[sb] * DBR + hq * 64 + d0) = w; } }
    }
}

__device__ __forceinline__ void gmlp_unit(LAS unsigned char* lds, const Ctx& P, int l, int unit) {
    const bf16_t* H = (const bf16_t*)(P.ws + WS_H); const bf16_t* SGW = (const bf16_t*)(P.ws + WS_SGW); bf16_t* O = (bf16_t*)(P.ws + WS_O);
    const float* lng = P.in[4] + l * DBR; const float* lnb = P.in[5] + l * DBR; const float* sgb = P.in[7] + l * 8 * 128;
    LAS float* stats = (LAS float*)lds; LAS bf16_t* vT = (LAS bf16_t*)(lds + 1024);
    const int hf = unit & 1, bc = unit >> 1; const size_t tok0 = (size_t)bc * 128;
    const int tid = opaque_tid(), wid = tid >> 6, lane = tid & 63, c = lane & 15, i = lane >> 4;
    __syncthreads();
#pragma unroll 2
    for (int r = 0; r < 16; ++r) { const int t = wid * 16 + r; const bf16_t* row = H + (tok0 + t) * LDH + C_V;
        const u32x4 a = *(const u32x4*)(row + lane * 8), bb = *(const u32x4*)(row + 512 + lane * 8);
        const float x[16] = {bflo(a.x), bfhi(a.x), bflo(a.y), bfhi(a.y), bflo(a.z), bfhi(a.z), bflo(a.w), bfhi(a.w), bflo(bb.x), bfhi(bb.x), bflo(bb.y), bfhi(bb.y), bflo(bb.z), bfhi(bb.z), bflo(bb.w), bfhi(bb.w)};
        float s = 0.f;
#pragma unroll
        for (int e = 0; e < 16; ++e) s += x[e];
        const float mean = wave_sum(s) * (1.0f / 1024.0f); float q = 0.f;
#pragma unroll
        for (int e = 0; e < 16; ++e) q += (x[e] - mean) * (x[e] - mean);
        const float var = wave_sum(q) * (1.0f / 1024.0f);
        if (lane == 0) { stats[2 * t] = mean; stats[2 * t + 1] = rsqrtf(var + 1e-5f); } }
    __syncthreads();
    for (int gi = 0; gi < 4; ++gi) { const int g = hf * 4 + gi;
        { const int s = tid & 127, dseg = tid >> 7; const float mean = stats[2 * s], rstd = stats[2 * s + 1];
            const bf16_t* row = H + (tok0 + s) * LDH + C_V + g * 128 + dseg * 32;
#pragma unroll
            for (int q4 = 0; q4 < 4; ++q4) { const u32x4 w = *(const u32x4*)(row + q4 * 8);
                const float x[8] = {bflo(w.x), bfhi(w.x), bflo(w.y), bfhi(w.y), bflo(w.z), bfhi(w.z), bflo(w.w), bfhi(w.w)};
                const int chb = g * 128 + dseg * 32 + q4 * 8; const f32x4 g0 = *(const f32x4*)(lng + chb), g1 = *(const f32x4*)(lng + chb + 4), b0 = *(const f32x4*)(lnb + chb), b1 = *(const f32x4*)(lnb + chb + 4);
#pragma unroll
                for (int e = 0; e < 8; ++e) { const int d = dseg * 32 + q4 * 8 + e;
                    const float val = (x[e] - mean) * rstd * (e < 4 ? g0[e & 3] : g1[e & 3]) + (e < 4 ? b0[e & 3] : b1[e & 3]); vT[d * 136 + s] = (bf16_t)(cvt_pk_bf16(val, 0.f) & 0xffffu); } } }
        __syncthreads();
        f32x4 acc[8];
#pragma unroll
        for (int nt = 0; nt < 8; ++nt) acc[nt] = (f32x4){0.f, 0.f, 0.f, 0.f};
        const int nks = (16 * wid + 15) / 32 + 1;
        for (int ks = 0; ks < nks; ++ks) { const bf16x8 wf = *(const bf16x8*)(SGW + ((size_t)(g * 128 + 16 * wid + c)) * 128 + ks * 32 + 8 * i);
#pragma unroll
            for (int nt = 0; nt < 8; ++nt) { const bf16x8 vf = *(const LAS bf16x8*)(vT + (16 * nt + c) * 136 + ks * 32 + 8 * i); acc[nt] = mfma16(vf, wf, acc[nt]); } }
        { const int t = 16 * wid + c; const size_t tok = tok0 + t; const float bs = sgb[g * 128 + t];
#pragma unroll
            for (int nt = 0; nt < 8; ++nt) { const int ch0 = g * 128 + 16 * nt + 4 * i;
                const u32x2 uu = *(const u32x2*)(H + tok * LDH + C_U + ch0), gg = *(const u32x2*)(H + tok * LDH + C_GA + ch0);
                u32x2 w; w.x = cvt_pk_bf16((acc[nt][0] + bs) * bflo(uu.x) * bflo(gg.x), (acc[nt][1] + bs) * bfhi(uu.x) * bfhi(gg.x));
                w.y = cvt_pk_bf16((acc[nt][2] + bs) * bflo(uu.y) * bflo(gg.y), (acc[nt][3] + bs) * bfhi(uu.y) * bfhi(gg.y));
                *(u32x2*)(O + tok * DBR + ch0) = w; } }
        __syncthreads();
    }
}

__device__ __forceinline__ void lru_a_unit(LAS unsigned char* lds, const Ctx& P, int l, int unit) {
    const bf16_t* H = (const bf16_t*)(P.ws + WS_H); const bf16_t* WAT = (const bf16_t*)(P.ws + WS_WAT);
    unsigned* LRW = (unsigned*)(P.ws + WS_LRA);
    const float* cw = P.in[8] + l * 4 * DBR; const float* cb = P.in[9] + l * DBR; const float* ba = P.in[11] + l * DBR; const float* bx = P.in[13] + l * DBR; const float* SP8 = (const float*)(P.ws + WS_PEW1) + 512;
    LAS bf16_t* xc = (LAS bf16_t*)lds; const LAS bf16_t* wl = (const LAS bf16_t*)(lds + 34816);
    const int n = unit & 7, bc = unit >> 3, b = bc >> 5, ck = bc & 31;
    const int tid = opaque_tid(), wid = tid >> 6, lane = tid & 63, c = lane & 15, i = lane >> 4;
    __syncthreads();
    { const int t = tid >> 2, dseg = tid & 3, pos = ck * 128 + t;
        u32x4 xr[4][4];
#pragma unroll
        for (int k = 0; k < 4; ++k) { const int pp = pos - 3 + k;
#pragma unroll
            for (int q4 = 0; q4 < 4; ++q4) { xr[k][q4] = (u32x4){0u, 0u, 0u, 0u};
                if (pp >= 0) xr[k][q4] = *(const u32x4*)(H + ((size_t)b * SEQ + pp) * LDH + C_XB + n * 128 + dseg * 32 + q4 * 8); } }
#pragma unroll
        for (int q4 = 0; q4 < 4; ++q4) { const int ch0 = n * 128 + dseg * 32 + q4 * 8; float a8[8];
            { const f32x4 c0 = *(const f32x4*)(cb + ch0), c1 = *(const f32x4*)(cb + ch0 + 4);
#pragma unroll
                for (int e = 0; e < 4; ++e) { a8[e] = c0[e]; a8[4 + e] = c1[e]; } }
#pragma unroll
            for (int k = 0; k < 4; ++k) { const u32x4 w = xr[k][q4];
                const f32x4 w0 = *(const f32x4*)(cw + k * DBR + ch0), w1 = *(const f32x4*)(cw + k * DBR + ch0 + 4);
                const float x[8] = {bflo(w.x), bfhi(w.x), bflo(w.y), bfhi(w.y), bflo(w.z), bfhi(w.z), bflo(w.w), bfhi(w.w)};
#pragma unroll
                for (int e = 0; e < 4; ++e) { a8[e] += w0[e] * x[e]; a8[4 + e] += w1[e] * x[4 + e]; } }
            u32x4 w; w.x = cvt_pk_bf16(a8[0], a8[1]); w.y = cvt_pk_bf16(a8[2], a8[3]); w.z = cvt_pk_bf16(a8[4], a8[5]); w.w = cvt_pk_bf16(a8[6], a8[7]);
            *(LAS u32x4*)(xc + t * 136 + dseg * 32 + q4 * 8) = w; } }
    __syncthreads();
    bf16x8 yf[4];
#pragma unroll
    for (int ks = 0; ks < 4; ++ks) yf[ks] = *(const LAS bf16x8*)(xc + (16 * wid + c) * 136 + ks * 32 + 8 * i);
    const int t = 16 * wid + c; const size_t tok = (size_t)bc * 128 + t;
#pragma unroll
    for (int nt = 0; nt < 8; ++nt) { f32x4 aA = (f32x4){0.f, 0.f, 0.f, 0.f}, aX = (f32x4){0.f, 0.f, 0.f, 0.f};
#pragma unroll
        for (int ks = 0; ks < 4; ++ks) { const bf16x8 wa = *(const LAS bf16x8*)(wl + (16 * nt + c) * 136 + ks * 32 + 8 * i);
            const bf16x8 wx = *(const LAS bf16x8*)(wl + (128 + 16 * nt + c) * 136 + ks * 32 + 8 * i);
            aA = mfma16(wa, yf[ks], aA); aX = mfma16(wx, yf[ks], aX); }
        const int e0 = 16 * nt + 4 * i, ch0 = n * 128 + e0; const u32x2 xw = *(const LAS u32x2*)(xc + t * 136 + e0);
        const float xv[4] = {bflo(xw.x), bfhi(xw.x), bflo(xw.y), bfhi(xw.y)}; f32x4 av, gv;
        const f32x4 bav = *(const f32x4*)(ba + ch0), bxv = *(const f32x4*)(bx + ch0), spv = *(const f32x4*)(SP8 + ch0);
#pragma unroll
        for (int r = 0; r < 4; ++r) { const float rr = sigmoidf_(aA[r] + bav[r]), ii = sigmoidf_(aX[r] + bxv[r]);
            const float a = __expf(-rr * spv[r]);
            av[r] = a; gv[r] = __builtin_amdgcn_sqrtf(fmaxf(1.0f - a * a, 0.f)) * ii * xv[r]; }
        u32x4 pw;
#pragma unroll
        for (int r = 0; r < 4; ++r) { const float am = fmaxf(1.0f - __expf(-spv[r]), 1e-30f);
            const unsigned q = (unsigned)fminf((1.0f - av[r]) * (65535.0f * __builtin_amdgcn_rcpf(am)) + 0.5f, 65535.0f); pw[r] = (cvt_pk_bf16(0.f, gv[r]) & 0xffff0000u) | q; }
        *(u32x4*)(LRW + tok * DBR + ch0) = pw; }
}

__device__ __forceinline__ void fast_sync(unsigned* ctl, unsigned gen, unsigned nwg) {
    __syncthreads();
    if (threadIdx.x == 0) {
        __builtin_amdgcn_fence(__ATOMIC_RELEASE, "agent");
        asm volatile("s_waitcnt vmcnt(0) lgkmcnt(0)" ::: "memory");
        bool last = false;
        if (__hip_atomic_fetch_add(ctl + 256 + 32 * (blockIdx.x & 7), 1u, __ATOMIC_RELAXED, __HIP_MEMORY_SCOPE_AGENT) == gen * (nwg >> 3) - 1u) {
            if (__hip_atomic_fetch_add(ctl, 1u, __ATOMIC_RELAXED, __HIP_MEMORY_SCOPE_AGENT) == gen * 8u - 1u) { __hip_atomic_store(ctl + 32, gen, __ATOMIC_RELAXED, __HIP_MEMORY_SCOPE_AGENT); last = true; } }
        if (!last) while (__hip_atomic_load(ctl + 32, __ATOMIC_RELAXED, __HIP_MEMORY_SCOPE_AGENT) < gen) __builtin_amdgcn_s_sleep(1);
        __builtin_amdgcn_fence(__ATOMIC_ACQUIRE, "agent");
        asm volatile("s_waitcnt vmcnt(0) lgkmcnt(0)" ::: "memory");
    }
    __syncthreads();
}

__global__ void __launch_bounds__(512, 2) fwd_megakernel(Params PK) {
    extern __shared__ __attribute__((aligned(16))) unsigned char lds_raw[];
    LAS unsigned char* lds = (LAS unsigned char*)lds_raw;
    cg::grid_group grid = cg::this_grid();
    LAS u64_t* pl = (LAS u64_t*)(lds + PL_OFF);
    if (threadIdx.x == 0) {
#pragma unroll
        for (int k = 0; k < 27; ++k) pl[k] = (u64_t)PK.in[k];
        pl[27] = (u64_t)PK.out; pl[28] = (u64_t)PK.ws; }
    __syncthreads();
    const int G = gridDim.x, bid = blockIdx.x;
    const size_t gstride = (size_t)G * 512;
    const int ph_lo = PK.ph_lo, ph_hi = PK.ph_hi;
    unsigned nbar = 0u;

    for (int gp = ph_lo; gp < ph_hi; ++gp) {
        const int tid = opaque_tid(); const size_t gtid = (size_t)bid * 512 + tid;
        asm volatile("" ::: "memory");
        Ctx P; P.in.pl = pl; P.out = (float*)P.in[27]; P.ws = (unsigned char*)P.in[28];
        unsigned char* ws = P.ws; bf16_t* Hh = (bf16_t*)(ws + WS_H);
        const int l = gp >= 9 ? 1 : 0; const int ph = gp == 0 ? 0 : (gp <= 8 ? gp : (gp == 16 ? 8 : gp - 8));
        if (gp == 0) prologue(lds, P, 0);
        else if (ph == 1) {
            { pg8::SchedStd S{64, 75, G, bid, DM, (const bf16_t*)(ws + (l == 0 ? WS_XB : WS_XB2)), (const bf16_t*)(ws + WS_WIN)}; pg8::EpiInProj E{Hh, ws + WS_G8}; pg8::gemm_phase(lds, DM, S, E); }
            { pg8::SchedStd S{4, 8, G, G - 1 - bid, DM, (const bf16_t*)(ws + WS_MEMB), (const bf16_t*)(ws + WS_WMEM)}; pg8::EpiBf16 E{(bf16_t*)(ws + WS_MKV), DM, 0, nullptr, 0, 0}; pg8::gemm_phase(lds, DM, S, E); }
        } else if (ph == 2) {
            for (int u = bid; u < 256; u += G) gmlp_unit(lds, P, l, u);
            { int cur_n = -1;
                for (int u = bid; u < 1024; u += G) { const int n = u & 7;
                    if (n != cur_n) { __syncthreads(); const bf16_t* WAT = (const bf16_t*)(ws + WS_WAT); LAS bf16_t* wl = (LAS bf16_t*)(lds + 34816);
                        for (int q = tid; q < 2 * 128 * 16; q += 512) { const int mat = q >> 11, r = (q >> 4) & 127, sg = q & 15;
                            *(LAS u32x4*)(wl + (mat * 128 + r) * 136 + sg * 8) = *(const u32x4*)(WAT + ((size_t)(mat * 8 + n) * 128 + r) * 128 + sg * 8); }
                        cur_n = n; __syncthreads(); }
                    lru_a_unit(lds, P, l, u); } }
            { bf16_t* A0 = (bf16_t*)(ws + WS_A0);
                for (size_t idx = gtid; idx < (size_t)2 * 4096 * 256; idx += gstride) { const int ch = (int)(idx & 255), row = (int)((idx >> 8) & 4095), kv = (int)(idx >> 20);
                    const int j = ch >> 3, d8 = (ch & 7) * 8, bh = row >> 8, n = row & 255, b = bh >> 2, hkv = bh & 3;
                    u32x4 v = (u32x4){0u, 0u, 0u, 0u};
                    if (n < 255) v = *(const u32x4*)(Hh + ((size_t)b * SEQ + 16 * n + j) * LDH + (kv ? C_VC : C_KC) + hkv * 64 + d8);
                    *(u32x4*)(A0 + ((size_t)kv * 4096 + row) * 2048 + j * 64 + d8) = v; } }
            __syncthreads();
            for (int u = bid; u < 512; u += G) memattn_unit(lds, P, u);
        } else if (ph == 3) {
            { const unsigned* LRW = (const unsigned*)(ws + WS_LRA); float* AGP = (float*)(ws + WS_AGG); float* AGH = AGP + 128 * 1024;
                for (size_t id = gtid; id < (size_t)128 * 1024; id += gstride) { const int ch = (int)(id & 1023), bc = (int)(id >> 10); const size_t base = (size_t)bc * 128 * DBR + ch;
                    float p = 1.f, h = 0.f; const float sc = fmaxf(1.0f - __expf(-((const float*)(ws + WS_PEW1))[512 + ch]), 1e-30f) * (1.0f / 65535.0f);
#pragma unroll 8
                    for (int t = 0; t < 128; ++t) { const unsigned w = LRW[base + (size_t)t * DBR]; const float a = 1.0f - (float)(w & 0xffffu) * sc, g = bfhi(w); p *= a; h = a * h + g; }
                    AGP[id] = p; AGH[id] = h; } }
            { pg8::SchedCmp1 S{bid, (const bf16_t*)(ws + WS_A0), (const bf16_t*)(ws + WS_W1T)}; pg8::EpiBf16 E{(bf16_t*)(ws + WS_HID), 256, (size_t)4096 * 256, (const float*)(ws + WS_PEW1), 256, 2}; pg8::gemm_phase(lds, 2048, S, E); }
        } else if (ph == 4) {
            { const unsigned* LRW = (const unsigned*)(ws + WS_LRA); const float* AGP = (const float*)(ws + WS_AGG); const float* AGH = AGP + 128 * 1024;
                bf16_t* Ob = (bf16_t*)(ws + WS_O) + (size_t)1 * MT * DBR;
                for (size_t id = gtid; id < (size_t)128 * 1024; id += gstride) { const int ch = (int)(id & 1023), bc = (int)(id >> 10), b = bc >> 5, ck = bc & 31; const size_t base = (size_t)bc * 128 * DBR + ch;
                    float h = 0.f; const float sc = fmaxf(1.0f - __expf(-((const float*)(ws + WS_PEW1))[512 + ch]), 1e-30f) * (1.0f / 65535.0f);
                    for (int j = 0; j < ck; ++j) { const size_t a = (size_t)(b * 32 + j) * 1024 + ch; h = AGP[a] * h + AGH[a]; }
#pragma unroll 8
                    for (int t = 0; t < 128; ++t) { const unsigned w = LRW[base + (size_t)t * DBR]; const float a = 1.0f - (float)(w & 0xffffu) * sc, g = bfhi(w); h = a * h + g;
                        const float sg = bf2f(Hh[((size_t)bc * 128 + t) * LDH + C_GB + ch]);
                        Ob[base + (size_t)t * DBR] = (bf16_t)(cvt_pk_bf16(h * sg, 0.f) & 0xffffu); } } }
            { const bf16_t* HID = (const bf16_t*)(ws + WS_HID); bf16_t* KCV = (bf16_t*)(ws + WS_KCV);
                for (size_t id = gtid; id < (size_t)2 * 4096 * 16; id += gstride) { const int e4 = (int)(id & 15) * 4, row = (int)((id >> 4) & 4095), kv = (int)(id >> 16);
                    const float* w2 = P.in[19 + kv] + (size_t)l * 256 * 64; const bf16_t* hr = HID + ((size_t)kv * 4096 + row) * 256; f32x4 a = (f32x4){0.f, 0.f, 0.f, 0.f};
#pragma unroll 8
                    for (int k = 0; k < 256; k += 2) { const unsigned hw = *(const unsigned*)(hr + k);
                        a += *(const f32x4*)(w2 + (size_t)k * 64 + e4) * bflo(hw); a += *(const f32x4*)(w2 + (size_t)(k + 1) * 64 + e4) * bfhi(hw); }
                    u32x2 w; w.x = cvt_pk_bf16(a[0], a[1]); w.y = cvt_pk_bf16(a[2], a[3]); *(u32x2*)(KCV + ((size_t)kv * 4096 + row) * 64 + e4) = w; } }
        } else if (ph == 5) {
            int cur_hkv = -1;
            for (int u = bid; u < 1024; u += G) { const int v = u & 255, k = u >> 8, x = v >> 4, b = (v >> 2) & 3, hkv = v & 3, tb = (k & 1) ? 16 * k + 15 - x : 16 * k + x;
                if (hkv != cur_hkv) { __syncthreads(); const float* src = (const float*)(ws + WS_LUT) + (size_t)hkv * 4 * 4096; LAS float* dst = (LAS float*)(lds + NSA_LUT);
                    for (int q = tid; q < 4096; q += 512) dst[q] = src[(q >> 10) * 4096 + (q & 1023)];
                    cur_hkv = hkv; __syncthreads(); }
                nsa_unit(lds, P, l, b, hkv, tb); }
        } else if (ph == 6) {
            pg8::SchedMerge S{G, bid, (const bf16_t*)(ws + WS_O), (const bf16_t*)(ws + WS_WBR)}; pg8::EpiMerge E{(bf16_t*)(ws + WS_XB), ws + WS_G8}; pg8::gemm_phase(lds, DBR, S, E);
        } else if (ph == 7) {
            pg8::SchedOut S{bid, (const bf16_t*)(ws + WS_XB), (const bf16_t*)(ws + WS_WOUT)};
            pg8::EpiOutLN E{l == 0 ? P.in[0] : (const float*)P.out, P.out, l == 0 ? (bf16_t*)(ws + WS_XB2) : (bf16_t*)nullptr, P.in[25] + l * DM, P.in[26] + l * DM,
                            (unsigned*)ws + 64 + l * 64, (unsigned long long*)(ws + WS_LNX), lds + 131072};
            pg8::gemm_phase(lds, DM, S, E);
        } else if (ph == 8) {
            if (l == 0) prologue(lds, P, 1);
        }
        if (gp + 1 < ph_hi) { if (gp == ph_lo) grid.sync(); else { ++nbar; fast_sync((unsigned*)ws, nbar, (unsigned)G); } }
    }
}

extern "C" void kernel_launch(void* const* d_in, const int* in_sizes, int n_in, void* d_out, int out_size, void* d_ws, size_t ws_size, hipStream_t stream) {
    static int grid_blocks = 0;
    if (grid_blocks == 0) {
        if (n_in != 27 || ws_size < WS_END) { fprintf(stderr, "kernel_launch: unexpected n_in %d or ws_size %zu (< %zu)\n", n_in, ws_size, (size_t)WS_END); grid_blocks = -1; return; }
        int dev = 0, cus = 0, per_cu = 0;
        hipGetDevice(&dev); hipDeviceGetAttribute(&cus, hipDeviceAttributeMultiprocessorCount, dev);
        if (hipFuncSetAttribute((const void*)fwd_megakernel, hipFuncAttributeMaxDynamicSharedMemorySize, LDS_BYTES) != hipSuccess) { fprintf(stderr, "kernel_launch: hipFuncSetAttribute failed\n"); grid_blocks = -1; return; }
        hipOccupancyMaxActiveBlocksPerMultiprocessor(&per_cu, (const void*)fwd_megakernel, 512, LDS_BYTES);
        (void)hipGetLastError();
        if (per_cu < 1) per_cu = 1;
        if (cus < 256) { fprintf(stderr, "kernel_launch: built for a 256-CU device (got %d CUs); nothing launched\n", cus); grid_blocks = -1; return; }
        grid_blocks = 256;
        fprintf(stderr, "kernel_launch: cus %d per_cu %d grid %d\n", cus, per_cu, grid_blocks);
    }
    if (grid_blocks < 0) return;
    if (hipMemsetAsync(d_ws, 0, 4096, stream) != hipSuccess) { fprintf(stderr, "kernel_launch: hipMemsetAsync failed\n"); return; }
    Params p{};
    for (int i = 0; i < 27; ++i) p.in[i] = (const float*)d_in[i];
    p.out = (float*)d_out; p.ws = (unsigned char*)d_ws; p.ph_lo = 0; p.ph_hi = 16;
    void* args[] = {&p};
    hipError_t e = hipLaunchCooperativeKernel((const void*)fwd_megakernel, dim3(grid_blocks), dim3(512), args, LDS_BYTES, stream);
    if (e != hipSuccess) fprintf(stderr, "cooperative launch failed: %s (grid %d)\n", hipGetErrorString(e), grid_blocks);
}
```

```cpp
#include <hip/hip_runtime.h>
#include <hip/hip_cooperative_groups.h>
#include <cstdio>
namespace cg = cooperative_groups;

#define LAS __attribute__((address_space(3)))
typedef unsigned short bf16_t;
typedef short bf16x8 __attribute__((ext_vector_type(8)));
typedef float f32x4 __attribute__((ext_vector_type(4)));
typedef unsigned u32x4 __attribute__((ext_vector_type(4)));
typedef unsigned u32x2 __attribute__((ext_vector_type(2)));

constexpr int SEQ = 4096, MT = 16384, DM = 2048, DBR = 1024, NIN = 19200  , LDH = 11008  , INW = 18992;
constexpr int C_U = 0, C_V = 1024, C_GA = 2048, C_XB = 3072, C_GB = 4096, C_Q = 5120, C_KC = 6144, C_VC = 6400, C_KS = 6656, C_VS = 6912,
              C_KW = 7168, C_VW = 7424, C_GC = 7680, C_QM = 8704, C_GM = 9728, C_GL = 10752  , N_GMG = 10752, N_GL = 18944  ;
constexpr float LOG2E = 1.4426950408889634f;
constexpr float NEGBIG = -1e30f;

constexpr size_t WS_XB   = 4096;
constexpr size_t WS_WIN  = WS_XB   + (size_t)MT * DM * 2;
constexpr size_t WS_WBR  = WS_WIN  + (size_t)NIN * DM * 2;
constexpr size_t WS_WOUT = WS_WBR  + (size_t)4 * DM * DBR * 2;
constexpr size_t WS_WMEM = WS_WOUT + (size_t)DM * DM * 2;
constexpr size_t WS_MEMB = WS_WMEM + (size_t)DM * DM * 2;
constexpr size_t WS_W1T  = WS_MEMB + (size_t)1024 * DM * 2;
constexpr size_t WS_WAT  = WS_W1T  + (size_t)2 * 256 * 2048 * 2;
constexpr size_t WS_SGW  = WS_WAT  + (size_t)2 * 8 * 128 * 128 * 2;
constexpr size_t WS_LUT  = WS_SGW  + (size_t)8 * 128 * 128 * 2;
constexpr size_t WS_PEW1 = WS_LUT  + (size_t)16 * 4096 * 4;
constexpr size_t WS_H    = WS_PEW1 + 8192;
constexpr size_t WS_MKV  = WS_H    + (size_t)MT * LDH * 2;
constexpr size_t WS_LRA  = WS_MKV  + (size_t)1024 * DM * 2;
constexpr size_t WS_LRG  = WS_LRA  + (size_t)MT * DBR * 4;
constexpr size_t WS_O    = WS_LRG  + (size_t)MT * DBR * 4;
constexpr size_t WS_A0   = WS_O    + (size_t)4 * MT * DBR * 2;
constexpr size_t WS_HID  = WS_A0   + (size_t)2 * 4096 * 2048 * 2;
constexpr size_t WS_KCV  = WS_HID  + (size_t)2 * 4096 * 256 * 2;
constexpr size_t WS_AGG  = WS_KCV  + (size_t)2 * 4096 * 64 * 2;
constexpr size_t WS_PARK = WS_AGG  + (size_t)2 * 128 * 1024 * 4;
constexpr size_t WS_G8   = WS_PARK + (size_t)256 * 8 * 8 * 64 * 16;
constexpr size_t WS_XB2  = WS_G8   + (size_t)MT * 8192;
constexpr size_t WS_LNX  = WS_XB2  + (size_t)MT * DM * 2;
constexpr size_t WS_END  = WS_LNX  + (size_t)64 * 256 * 8 * 8;

constexpr int LDS_BYTES = 147456, PL_OFF = 147200;

struct Params {
    const float* in[27];
    float* out;
    unsigned char* ws;
    int ph_lo, ph_hi;
};
typedef unsigned long long u64_t;
struct InAcc { const LAS u64_t* pl;
    __device__ __forceinline__ const float* operator[](int k) const { const u64_t v = pl[k];
        const unsigned lo = __builtin_amdgcn_readfirstlane((unsigned)v), hi = __builtin_amdgcn_readfirstlane((unsigned)(v >> 32)); return (const float*)(const __attribute__((address_space(1))) float*)(((u64_t)hi << 32) | lo); } };
struct Ctx { InAcc in; float* out; unsigned char* ws; };

__device__ __forceinline__ unsigned cvt_pk_bf16(float lo, float hi) { unsigned r; asm("v_cvt_pk_bf16_f32 %0, %1, %2" : "=v"(r) : "v"(lo), "v"(hi)); return r; }
__device__ __forceinline__ float bflo(unsigned w) { return __uint_as_float(w << 16); }
__device__ __forceinline__ float bfhi(unsigned w) { return __uint_as_float(w & 0xffff0000u); }
__device__ __forceinline__ float bf2f(bf16_t v) { return __uint_as_float(((unsigned)v) << 16); }
__device__ __forceinline__ float sigmoidf_(float x) { return __builtin_amdgcn_rcpf(1.0f + __expf(-x)); }
__device__ __forceinline__ float siluf_(float x) { return x * __builtin_amdgcn_rcpf(1.0f + __expf(-x)); }
__device__ __forceinline__ float gelu_tanh(float x) { const float u = 0.7978845608028654f * (x + 0.044715f * x * x * x); return x * __builtin_amdgcn_rcpf(1.0f + __expf(-2.0f * u)); }
__device__ __forceinline__ float wave_sum(float v) {
#pragma unroll
    for (int o = 32; o >= 1; o >>= 1) v += __shfl_xor(v, o);
    return v; }
__device__ __forceinline__ float wave_max(float v) {
#pragma unroll
    for (int o = 32; o >= 1; o >>= 1) v = fmaxf(v, __shfl_xor(v, o));
    return v; }
__device__ __forceinline__ int opaque_tid() { int t = threadIdx.x; asm volatile("" : "+v"(t)); return t; }
__device__ __forceinline__ float rows_max(float x) {
    auto a = __builtin_amdgcn_permlane16_swap(__float_as_uint(x), __float_as_uint(x), false, false); x = fmaxf(__uint_as_float(a[0]), __uint_as_float(a[1]));
    auto b = __builtin_amdgcn_permlane32_swap(__float_as_uint(x), __float_as_uint(x), false, false); return fmaxf(__uint_as_float(b[0]), __uint_as_float(b[1])); }
__device__ __forceinline__ float rows_sum(float x) {
    auto a = __builtin_amdgcn_permlane16_swap(__float_as_uint(x), __float_as_uint(x), false, false); x = __uint_as_float(a[0]) + __uint_as_float(a[1]);
    auto b = __builtin_amdgcn_permlane32_swap(__float_as_uint(x), __float_as_uint(x), false, false); return __uint_as_float(b[0]) + __uint_as_float(b[1]); }
__device__ __forceinline__ f32x4 mfma16(bf16x8 a, bf16x8 b, f32x4 c) { return __builtin_amdgcn_mfma_f32_16x16x32_bf16(a, b, c, 0, 0, 0); }
__device__ __forceinline__ int rel_bucket(int n) {
    if (n < 16) return n < 0 ? 0 : n;
    return 16 + (n >= 21) + (n >= 27) + (n >= 35) + (n >= 46) + (n >= 59) + (n >= 77) + (n >= 99) + (n >= 128) + (n >= 166) + (n >= 216) + (n >= 280) + (n >= 363) + (n >= 470) + (n >= 609) + (n >= 790);
}

namespace pg8 {
constexpr int BM = 256, BK = 64, HALF = 128, HTB = HALF * BK * 2, STAGE_BYTES = 8 * HTB, NXCD = 8, WGM = 8;
__device__ __forceinline__ int lds_byte(int r, int c) { const int st = (r >> 4) * 2 + (c >> 5), rr = r & 15, cc = c & 31, ob = rr * 64 + cc * 2; return st * 1024 + (ob ^ (((ob >> 9) & 1) << 5)); }
__device__ __forceinline__ void stage_rc(int b, int& R, int& C) { const int st = b / 1024, sb = b % 1024, swz = sb ^ (((sb >> 9) & 1) << 5); R = (st >> 1) * 16 + swz / 64; C = (st & 1) * 32 + (swz % 64) / 2; }
__device__ __forceinline__ int perm32(int rho) { const int n = rho >> 4, i = rho & 15; return 8 * (i >> 2) + 4 * n + (i & 3); }
struct Unit { int pm, pn, z; };

__device__ __forceinline__ bool static_next(long L, int nM, int nN, Unit& u) {
    const int nwg = nM * nN; if (L >= nwg) return false;
    int wgid = (int)L; { const int q = nwg / NXCD, r = nwg % NXCD, xcd = wgid % NXCD, off = wgid / NXCD; wgid = (xcd < r ? xcd * (q + 1) : r * (q + 1) + (xcd - r) * q) + off; }
    const int nig = WGM * nN, gid = wgid / nig, fm = gid * WGM, gsz = (nM - fm) < WGM ? (nM - fm) : WGM;
    u.pm = fm + ((wgid % nig) % gsz); u.pn = (wgid % nig) / gsz; u.z = 0; return true;
}
struct SchedStd {
    int nM, nN, G, c, K; const bf16_t* A; const bf16_t* B;
    __device__ __forceinline__ bool next(int i, Unit& u) const { return static_next((long)i * G + c, nM, nN, u); }
    __device__ __forceinline__ const char* aptr(const Unit& u) const { return (const char*)(A + (size_t)u.pm * 256 * K); }
    __device__ __forceinline__ const char* bptr(const Unit& u) const { return (const char*)(B + (size_t)u.pn * 256 * K); }
};
struct SchedCmp1 {
    int c; const bf16_t* A0; const bf16_t* W1T;
    __device__ __forceinline__ bool next(int i, Unit& u) const { if (i > 0 || c >= 32) return false; u.z = c >> 4; u.pm = c & 15; u.pn = 0; return true; }
    __device__ __forceinline__ const char* aptr(const Unit& u) const { return (const char*)(A0 + ((size_t)u.z * 4096 + (size_t)u.pm * 256) * 2048); }
    __device__ __forceinline__ const char* bptr(const Unit& u) const { return (const char*)(W1T + (size_t)u.z * 256 * 2048); }
};
struct SchedMerge {
    int G, c; const bf16_t* O; const bf16_t* WBR;
    __device__ __forceinline__ bool next(int i, Unit& u) const { const bool ok = static_next((long)(i >> 2) * G + c, 64, 8, u); u.z = i & 3; return ok; }
    __device__ __forceinline__ const char* aptr(const Unit& u) const { return (const char*)(O + ((size_t)u.z * MT + (size_t)u.pm * 256) * DBR); }
    __device__ __forceinline__ const char* bptr(const Unit& u) const { return (const char*)(WBR + ((size_t)u.z * DM + (size_t)u.pn * 256) * DBR); }
};

struct SchedOut {
    int c; const bf16_t* A; const bf16_t* B;
    __device__ __forceinline__ bool next(int i, Unit& u) const { if (i > 1) return false; const int x = c & 7, k = c >> 3; u.pm = 32 * i + 4 * x + (k >> 3); u.pn = k & 7; u.z = 0; return true; }
    __device__ __forceinline__ const char* aptr(const Unit& u) const { return (const char*)(A + (size_t)u.pm * 256 * DM); }
    __device__ __forceinline__ const char* bptr(const Unit& u) const { return (const char*)(B + (size_t)u.pn * 256 * DM); }
};
template <class Epi, class Sched>
__device__ __forceinline__ void gemm_phase(LAS unsigned char* lds, const int K, const Sched& S, const Epi& E) {
    const int tid = opaque_tid(), wid = __builtin_amdgcn_readfirstlane(tid >> 6), lane = tid & 63, wr = wid >> 2, wc = wid & 3, fr = lane & 15, fq = lane >> 4;
    const int nt = K / BK;
    unsigned voffA[2], voffB[2];
#pragma unroll
    for (int i = 0; i < 2; ++i) { int R, C; stage_rc(tid * 16 + i * 8192, R, C); const int Rb = Epi::PERM ? ((R & ~31) + perm32(R & 31)) : R;
        voffA[i] = (unsigned)(R * K + C) * 2u; voffB[i] = (unsigned)(Rb * K + C) * 2u; }
    const size_t kstep = (size_t)(BK * 2);
    const size_t hstep = (size_t)HALF * K * 2;
    const unsigned ldsw = (unsigned)wid * 1024u;
    const int aoff = lds_byte(wr * 64 + fr, fq * 8), boff = lds_byte(wc * 32 + fr, fq * 8);
#define PG8_SA(b, h) (((b) * 2 + (h)) * HTB)
#define PG8_SB(b, h) ((4 + (b) * 2 + (h)) * HTB)
#define PG8_STAGE(bufoff, gbase, voff) do { _Pragma("unroll") for (int _i = 0; _i < 2; ++_i) \
        __builtin_amdgcn_global_load_lds((const unsigned*)((const char*)(gbase) + (voff)[_i]), (LAS unsigned*)(lds + (bufoff) + ldsw + _i * 8192), 16, 0, 0); } while (0)
#define PG8_LDA(dst, b, h) do { _Pragma("unroll") for (int m = 0; m < 4; ++m) _Pragma("unroll") for (int k = 0; k < 2; ++k) dst[m][k] = *(const LAS bf16x8*)(lds + PG8_SA(b, h) + aoff + m * 2048 + k * 1024); } while (0)
#define PG8_LDB(dst, b, h) do { _Pragma("unroll") for (int n = 0; n < 2; ++n) _Pragma("unroll") for (int k = 0; k < 2; ++k) dst[n][k] = *(const LAS bf16x8*)(lds + PG8_SB(b, h) + boff + n * 2048 + k * 1024); } while (0)
#define PG8_MMA(ai, bj, At, Bt) do { __builtin_amdgcn_s_setprio(1); _Pragma("unroll") for (int m = 0; m < 4; ++m) _Pragma("unroll") for (int n = 0; n < 2; ++n) _Pragma("unroll") for (int k = 0; k < 2; ++k) \
        acc[ai][bj][m][n] = __builtin_amdgcn_mfma_f32_16x16x32_bf16(Bt[n][k], At[m][k], acc[ai][bj][m][n], 0, 0, 0); __builtin_amdgcn_s_setprio(0); } while (0)
#define PG8_WAIT_V(n) asm volatile("s_waitcnt vmcnt(" #n ")" ::: "memory")
#define PG8_WAIT_L(n) asm volatile("s_waitcnt lgkmcnt(" #n ")" ::: "memory")
#define PG8_BAR __builtin_amdgcn_s_barrier()
#define PG8_SCHED __builtin_amdgcn_sched_barrier(0)
    Unit cur, nxt; int ui = 0;
    if (!S.next(0, cur)) return;
    f32x4 acc[2][2][4][2];
#pragma unroll
    for (int a = 0; a < 2; ++a)
#pragma unroll
        for (int b = 0; b < 2; ++b)
#pragma unroll
            for (int m = 0; m < 4; ++m)
#pragma unroll
                for (int n = 0; n < 2; ++n) acc[a][b][m][n] = (f32x4){0.f, 0.f, 0.f, 0.f};
    bf16x8 At[4][2], B0[2][2], B1[2][2];
    const char* cA = S.aptr(cur); const char* cB = S.bptr(cur);
    PG8_STAGE(PG8_SB(0, 0), cB, voffB); PG8_STAGE(PG8_SB(0, 1), cB + hstep, voffB); PG8_STAGE(PG8_SA(0, 0), cA, voffA); PG8_STAGE(PG8_SA(0, 1), cA + hstep, voffA);
    if (wr == 1) PG8_BAR;
    PG8_WAIT_V(2); PG8_BAR;
    PG8_STAGE(PG8_SB(1, 0), cB + kstep, voffB); PG8_STAGE(PG8_SA(1, 0), cA + kstep, voffA); PG8_STAGE(PG8_SB(1, 1), cB + hstep + kstep, voffB);
    PG8_WAIT_V(6); PG8_BAR;
    for (;;) {
        const bool has_next = S.next(ui + 1, nxt);
        const char* nA = has_next ? S.aptr(nxt) : cA; const char* nB = has_next ? S.bptr(nxt) : cB;
        for (int t = 0; t < nt; t += 2) {
            const bool last = (t == nt - 2);
            const char* a1 = cA + (size_t)(t + 1) * kstep;
            const char* a2 = last ? nA : cA + (size_t)(t + 2) * kstep; const char* b2 = last ? nB : cB + (size_t)(t + 2) * kstep;
            const char* a3 = a2 + kstep; const char* b3 = b2 + kstep;
            PG8_LDB(B0, 0, 0); PG8_LDB(B1, 0, 1); PG8_SCHED; PG8_LDA(At, 0, 0); PG8_STAGE(PG8_SA(1, 1), a1 + hstep, voffA);
            PG8_WAIT_V(8); PG8_WAIT_L(0); PG8_BAR; PG8_MMA(0, 0, At, B0); PG8_MMA(0, 1, At, B1); PG8_BAR; PG8_SCHED;
            PG8_LDA(At, 0, 1); PG8_STAGE(PG8_SB(0, 0), b2, voffB); PG8_STAGE(PG8_SB(0, 1), b2 + hstep, voffB); PG8_STAGE(PG8_SA(0, 0), a2, voffA);
            PG8_WAIT_V(8); PG8_WAIT_L(0); PG8_BAR; PG8_MMA(1, 0, At, B0); PG8_MMA(1, 1, At, B1); PG8_BAR; PG8_SCHED;
            PG8_LDB(B0, 1, 0); PG8_LDB(B1, 1, 1); PG8_SCHED; PG8_LDA(At, 1, 0); PG8_STAGE(PG8_SA(0, 1), a2 + hstep, voffA);
            PG8_WAIT_V(8); PG8_WAIT_L(0); PG8_BAR; PG8_MMA(0, 0, At, B0); PG8_MMA(0, 1, At, B1); PG8_BAR; PG8_SCHED;
            PG8_LDA(At, 1, 1); PG8_STAGE(PG8_SB(1, 0), b3, voffB); PG8_STAGE(PG8_SB(1, 1), b3 + hstep, voffB); PG8_STAGE(PG8_SA(1, 0), a3, voffA);
            PG8_WAIT_V(8); PG8_WAIT_L(0); PG8_BAR; PG8_MMA(1, 0, At, B0); PG8_MMA(1, 1, At, B1); PG8_BAR; PG8_SCHED;
        }
        if (wr == 0) PG8_BAR;
        E(acc, cur, wr, wc, fr, fq);
        if (!has_next) break;
#pragma unroll
        for (int a = 0; a < 2; ++a)
#pragma unroll
            for (int b = 0; b < 2; ++b)
#pragma unroll
                for (int m = 0; m < 4; ++m)
#pragma unroll
                    for (int n = 0; n < 2; ++n) acc[a][b][m][n] = (f32x4){0.f, 0.f, 0.f, 0.f};
        cur = nxt; cA = nA; cB = nB; ++ui;
        if (wr == 1) PG8_BAR;
    }
    PG8_WAIT_V(0);
    PG8_BAR;
#undef PG8_SA
#undef PG8_SB
#undef PG8_STAGE
#undef PG8_LDA
#undef PG8_LDB
#undef PG8_MMA
#undef PG8_WAIT_V
#undef PG8_WAIT_L
#undef PG8_BAR
#undef PG8_SCHED
}

__device__ __forceinline__ int act_of(int col) {
    if (col < 2048) return 1; if (col < 3072) return 2; if (col < 4096) return 0; if (col < 5120) return 2; if (col < 7680) return 0;
    if (col < 8704) return 2; if (col < 9728) return 0; if (col < 10752) return 2; if (col < 18944) return 3; return 0;
}
struct EpiInProj {
    static constexpr bool PERM = true;
    bf16_t* H; unsigned char* G8;
    __device__ __forceinline__ void operator()(const f32x4 (&acc)[2][2][4][2], const Unit& u, int wr, int wc, int fr, int fq) const {
        const int row0 = u.pm * BM + wr * 64 + fr, colt = u.pn * BM;
        const int act = act_of(colt);
        if (act == 3) {
            unsigned char* gp = G8 + (colt - N_GMG) + wc * 32 + 8 * fq;
#pragma unroll
            for (int ai = 0; ai < 2; ++ai)
#pragma unroll
                for (int m = 0; m < 4; ++m) { unsigned char* rowp = gp + (size_t)(row0 + ai * HALF + m * 16) * 8192;
#pragma unroll
                    for (int bj = 0; bj < 2; ++bj) { unsigned q[8];
#pragma unroll
                        for (int n = 0; n < 2; ++n)
#pragma unroll
                            for (int j = 0; j < 4; j += 2) { typedef float f32x2 __attribute__((ext_vector_type(2)));
                                const f32x2 x = {acc[ai][bj][m][n][j], acc[ai][bj][m][n][j + 1]}; const f32x2 t = x * (-LOG2E);
                                f32x2 d = {__builtin_amdgcn_exp2f(t.x), __builtin_amdgcn_exp2f(t.y)}; d = d + 1.0f;
                                f32x2 r = {__builtin_amdgcn_rcpf(d.x), __builtin_amdgcn_rcpf(d.y)}; r = r * 255.0f + 0.5f;
                                q[4 * n + j] = (unsigned)r.x; q[4 * n + j + 1] = (unsigned)r.y; }
                        u32x2 w; w.x = q[0] | (q[1] << 8) | (q[2] << 16) | (q[3] << 24); w.y = q[4] | (q[5] << 8) | (q[6] << 16) | (q[7] << 24);
                        *(u32x2*)(rowp + bj * HALF) = w; } }
            return;
        }
        const int col0 = (colt >= N_GL ? C_GL : colt) + wc * 32 + 8 * fq;
        const float k1 = (act == 1) ? -1.5957691216057308f * LOG2E : -LOG2E, k3 = (act == 1) ? -1.5957691216057308f * 0.044715f * LOG2E : 0.f;
#pragma unroll
        for (int ai = 0; ai < 2; ++ai)
#pragma unroll
            for (int m = 0; m < 4; ++m) { bf16_t* rowp = H + (size_t)(row0 + ai * HALF + m * 16) * LDH + col0;
#pragma unroll
                for (int bj = 0; bj < 2; ++bj) { float v[8];
#pragma unroll
                    for (int j = 0; j < 4; ++j) { v[j] = acc[ai][bj][m][0][j]; v[4 + j] = acc[ai][bj][m][1][j]; }
                    if (act != 0) {
#pragma unroll
                        for (int j = 0; j < 8; j += 2) { typedef float f32x2 __attribute__((ext_vector_type(2)));
                            const f32x2 x = {v[j], v[j + 1]}; const f32x2 t = x * (x * x * k3 + k1);
                            f32x2 d = {__builtin_amdgcn_exp2f(t.x), __builtin_amdgcn_exp2f(t.y)}; d = d + 1.0f;
                            const f32x2 r = {__builtin_amdgcn_rcpf(d.x), __builtin_amdgcn_rcpf(d.y)}; const f32x2 y = x * r; v[j] = y.x; v[j + 1] = y.y; }
                    }
                    u32x4 w; w.x = cvt_pk_bf16(v[0], v[1]); w.y = cvt_pk_bf16(v[2], v[3]); w.z = cvt_pk_bf16(v[4], v[5]); w.w = cvt_pk_bf16(v[6], v[7]);
                    *(u32x4*)(rowp + bj * HALF) = w; } }
    }
};
struct EpiBf16 {
    static constexpr bool PERM = true;
    bf16_t* O; int ldc; size_t zstride; const float* bias; int zbias; int act;
    __device__ __forceinline__ void operator()(const f32x4 (&acc)[2][2][4][2], const Unit& u, int wr, int wc, int fr, int fq) const {
        const int row0 = u.pm * BM + wr * 64 + fr, col0 = u.pn * BM + wc * 32 + 8 * fq;
        bf16_t* base = O + (size_t)u.z * zstride;
#pragma unroll
        for (int ai = 0; ai < 2; ++ai)
#pragma unroll
            for (int m = 0; m < 4; ++m) { bf16_t* rowp = base + (size_t)(row0 + ai * HALF + m * 16) * ldc + col0;
#pragma unroll
                for (int bj = 0; bj < 2; ++bj) { float v[8];
#pragma unroll
                    for (int j = 0; j < 4; ++j) { v[j] = acc[ai][bj][m][0][j]; v[4 + j] = acc[ai][bj][m][1][j]; }
                    if (bias) {
#pragma unroll
                        for (int j = 0; j < 8; ++j) v[j] += bias[u.z * zbias + col0 + bj * HALF + j];
                    }
                    if (act == 2) {
#pragma unroll
                        for (int j = 0; j < 8; ++j) v[j] = siluf_(v[j]);
                    }
                    u32x4 w; w.x = cvt_pk_bf16(v[0], v[1]); w.y = cvt_pk_bf16(v[2], v[3]); w.z = cvt_pk_bf16(v[4], v[5]); w.w = cvt_pk_bf16(v[6], v[7]);
                    *(u32x4*)(rowp + bj * HALF) = w; } }
    }
};
struct EpiMerge {
    static constexpr bool PERM = true;
    bf16_t* Mg; const unsigned char* G8;
    __device__ __forceinline__ void operator()(const f32x4 (&acc)[2][2][4][2], const Unit& u, int wr, int wc, int fr, int fq) const {
        const int row0 = u.pm * BM + wr * 64 + fr, col0 = u.pn * BM + wc * 32 + 8 * fq;
        u32x2 g[2][4][2];
#pragma unroll
        for (int ai = 0; ai < 2; ++ai)
#pragma unroll
            for (int m = 0; m < 4; ++m) { const unsigned char* gp = G8 + (size_t)(row0 + ai * HALF + m * 16) * 8192 + u.z * DM + col0;
#pragma unroll
                for (int bj = 0; bj < 2; ++bj) g[ai][m][bj] = *(const u32x2*)(gp + bj * HALF); }
#pragma unroll
        for (int ai = 0; ai < 2; ++ai) {
            u32x4 p[4][2];
#pragma unroll
            for (int m = 0; m < 4; ++m)
#pragma unroll
                for (int bj = 0; bj < 2; ++bj) { p[m][bj] = (u32x4){0u, 0u, 0u, 0u}; if (u.z > 0) p[m][bj] = *(const u32x4*)(Mg + (size_t)(row0 + ai * HALF + m * 16) * DM + col0 + bj * HALF); }
#pragma unroll
            for (int m = 0; m < 4; ++m) { bf16_t* mp = Mg + (size_t)(row0 + ai * HALF + m * 16) * DM + col0;
#pragma unroll
                for (int bj = 0; bj < 2; ++bj) { const u32x2 gg = g[ai][m][bj]; const u32x4 pp = p[m][bj];
                    const f32x4 a0 = acc[ai][bj][m][0] * (1.0f / 255.0f), a1 = acc[ai][bj][m][1] * (1.0f / 255.0f);
                    const float v0 = (float)(gg.x & 255u) * a0[0] + bflo(pp.x), v1 = (float)((gg.x >> 8) & 255u) * a0[1] + bfhi(pp.x), v2 = (float)((gg.x >> 16) & 255u) * a0[2] + bflo(pp.y), v3 = (float)(gg.x >> 24) * a0[3] + bfhi(pp.y);
                    const float v4 = (float)(gg.y & 255u) * a1[0] + bflo(pp.z), v5 = (float)((gg.y >> 8) & 255u) * a1[1] + bfhi(pp.z), v6 = (float)((gg.y >> 16) & 255u) * a1[2] + bflo(pp.w), v7 = (float)(gg.y >> 24) * a1[3] + bfhi(pp.w);
                    u32x4 w; w.x = cvt_pk_bf16(v0, v1); w.y = cvt_pk_bf16(v2, v3); w.z = cvt_pk_bf16(v4, v5); w.w = cvt_pk_bf16(v6, v7);
                    *(u32x4*)(mp + bj * HALF) = w; } } }
    }
};
struct EpiOutLN {
    static constexpr bool PERM = false;
    const float* xres; float* out; bf16_t* xb; const float* lg; const float* lb; unsigned* cnt; unsigned long long* slots; LAS unsigned char* lx;
    __device__ __forceinline__ void operator()(f32x4 (&acc)[2][2][4][2], const Unit& u, int wr, int wc, int fr, int fq) const {
        typedef float f32x2v __attribute__((ext_vector_type(2)));
        LAS f32x2v* Pt = (LAS f32x2v*)lx;
        LAS f32x2v* St = (LAS f32x2v*)(lx + 8192);
        const int tid = opaque_tid(), wid = tid >> 6, lane = tid & 63;
        const int row0 = u.pm * BM + wr * 64 + fr, col0 = u.pn * BM + wc * 32 + 4 * fq;
#pragma unroll
        for (int ai = 0; ai < 2; ++ai)
#pragma unroll
            for (int m = 0; m < 4; ++m) { const size_t off = (size_t)(row0 + ai * HALF + m * 16) * DM + col0; float sm = 0.f;
#pragma unroll
                for (int bj = 0; bj < 2; ++bj)
#pragma unroll
                    for (int n = 0; n < 2; ++n) { const f32x4 x = *(const f32x4*)(xres + off + bj * HALF + n * 16); const f32x4 z = x * 1.4142135623730951f + acc[ai][bj][m][n];
                        acc[ai][bj][m][n] = z; sm += (z[0] + z[1]) + (z[2] + z[3]); }
                sm += __shfl_xor(sm, 16); sm += __shfl_xor(sm, 32);
                const float mw = sm * (1.0f / 64.0f); float q = 0.f;
#pragma unroll
                for (int bj = 0; bj < 2; ++bj)
#pragma unroll
                    for (int n = 0; n < 2; ++n) { const f32x4 d = acc[ai][bj][m][n] - mw; q += (d[0] * d[0] + d[1] * d[1]) + (d[2] * d[2] + d[3] * d[3]); }
                q += __shfl_xor(q, 16); q += __shfl_xor(q, 32);
                if (fq == 0) Pt[(ai * HALF + wr * 64 + m * 16 + fr) * 4 + wc] = (f32x2v){mw, q}; }
        __syncthreads();
        const int row = wid * 32 + (lane & 31);
        if (lane < 32) { const f32x2v a = Pt[row * 4 + 0], b = Pt[row * 4 + 1], c = Pt[row * 4 + 2], d = Pt[row * 4 + 3];
            const float mt = (a.x + b.x + c.x + d.x) * 0.25f; const float da = a.x - mt, db = b.x - mt, dc = c.x - mt, dd = d.x - mt;
            const float m2 = (a.y + b.y) + (c.y + d.y) + 64.0f * ((da * da + db * db) + (dc * dc + dd * dd));
            __hip_atomic_store(slots + ((size_t)(u.pm * BM + row) * 8 + u.pn), ((unsigned long long)__float_as_uint(m2) << 32) | __float_as_uint(mt), __ATOMIC_RELAXED, __HIP_MEMORY_SCOPE_AGENT); }
        asm volatile("s_waitcnt vmcnt(0)" ::: "memory");
        if (lane == 0) __hip_atomic_fetch_add(cnt + u.pm, 1u, __ATOMIC_RELAXED, __HIP_MEMORY_SCOPE_AGENT);
        if (wid == 0) { unsigned polls = 0;
            while ((unsigned)__builtin_amdgcn_readfirstlane(__hip_atomic_load(cnt + u.pm, __ATOMIC_RELAXED, __HIP_MEMORY_SCOPE_AGENT)) < 64u) { if (++polls > (1u << 22)) break; __builtin_amdgcn_s_sleep(2); }
            __builtin_amdgcn_fence(__ATOMIC_ACQUIRE, "agent"); }
        asm volatile("s_waitcnt vmcnt(0) lgkmcnt(0)" ::: "memory");
        __syncthreads();
        if (lane < 32) { const unsigned long long* sl = slots + (size_t)(u.pm * BM + row) * 8; float mt[8], m2[8]; float ms = 0.f;
#pragma unroll
            for (int t = 0; t < 8; ++t) { const unsigned long long w = __hip_atomic_load(sl + t, __ATOMIC_RELAXED, __HIP_MEMORY_SCOPE_AGENT); mt[t] = __uint_as_float((unsigned)w); m2[t] = __uint_as_float((unsigned)(w >> 32)); ms += mt[t]; }
            const float mean = ms * 0.125f; float q = 0.f;
#pragma unroll
            for (int t = 0; t < 8; ++t) { const float dm = mt[t] - mean; q += m2[t] + 256.0f * dm * dm; }
            St[row] = (f32x2v){mean, rsqrtf(q * (1.0f / 2048.0f) + 1e-5f)}; }
        __syncthreads();
#pragma unroll
        for (int ai = 0; ai < 2; ++ai)
#pragma unroll
            for (int m = 0; m < 4; ++m) { const int rl = ai * HALF + wr * 64 + m * 16 + fr; const f32x2v sr = St[rl]; const size_t off = (size_t)(u.pm * BM + rl) * DM + col0;
#pragma unroll
                for (int bj = 0; bj < 2; ++bj)
#pragma unroll
                    for (int n = 0; n < 2; ++n) { const int co = bj * HALF + n * 16; const f32x4 gg = *(const f32x4*)(lg + col0 + co), bb = *(const f32x4*)(lb + col0 + co);
                        const f32x4 y = (acc[ai][bj][m][n] - sr.x) * sr.y * gg + bb; *(f32x4*)(out + off + co) = y;
                        if (xb) { u32x2 w; w.x = cvt_pk_bf16(y[0], y[1]); w.y = cvt_pk_bf16(y[2], y[3]); *(u32x2*)(xb + off + co) = w; } } }
        __syncthreads();
    }
};
}

__device__ __forceinline__ void tconv_tile(LAS float* tile, const float* src, int ld, int k0, int n0, int mode, bf16_t* dst, int K) {
    const int tid = opaque_tid();
#pragma unroll
    for (int it = 0; it < 2; ++it) { const int idx = tid + it * 512, kk = idx >> 4, n4 = (idx & 15) * 4, nn = n0 + n4; int oc = nn; bool valid = true;
        if (mode == 1) { if (nn < 7680) oc = nn; else if (nn < 18944) oc = nn + 48; else if (nn < INW) oc = 7680 + (nn - 18944); else valid = false; }
        f32x4 v = (f32x4){0.f, 0.f, 0.f, 0.f}; if (valid) v = *(const f32x4*)(src + (size_t)(k0 + kk) * ld + oc);
        tile[kk * 65 + n4 + 0] = v[0]; tile[kk * 65 + n4 + 1] = v[1]; tile[kk * 65 + n4 + 2] = v[2]; tile[kk * 65 + n4 + 3] = v[3]; }
    __syncthreads();
    { const int n = tid >> 3, k8 = (tid & 7) * 8; float v[8];
#pragma unroll
        for (int e = 0; e < 8; ++e) v[e] = tile[(k8 + e) * 65 + n];
        u32x4 w; w.x = cvt_pk_bf16(v[0], v[1]); w.y = cvt_pk_bf16(v[2], v[3]); w.z = cvt_pk_bf16(v[4], v[5]); w.w = cvt_pk_bf16(v[6], v[7]);
        *(u32x4*)(dst + (size_t)(n0 + n) * K + k0 + k8) = w; }
    __syncthreads();
}

__device__ __forceinline__ void prologue(LAS unsigned char* lds, const Ctx& P, int l) {
    unsigned char* ws = P.ws; LAS float* tile = (LAS float*)lds;
    const int tid = opaque_tid(), G = gridDim.x;
    const int T_IN = 32 * 300, T_BR = 4 * 512, T_OUT = 1024, T_MEM = 1024, T_W1 = 256, T_WA = 64;
    const int T_ALL = T_IN + T_BR + T_OUT + T_MEM + T_W1 + T_WA;
    for (int t = blockIdx.x; t < T_ALL; t += G) {
        int q = t;
        if (q < T_IN) { const int kt = q & 31, ntl = q >> 5; tconv_tile(tile, P.in[3] + (size_t)l * DM * INW, INW, kt * 64, ntl * 64, 1, (bf16_t*)(ws + WS_WIN), DM); continue; }
        q -= T_IN;
        if (q < T_BR) { const int br = q >> 9, r = q & 511, kt = r & 15, ntl = r >> 4;
            tconv_tile(tile, P.in[23] + ((size_t)l * 4 + br) * DBR * DM, DM, kt * 64, ntl * 64, 0, (bf16_t*)(ws + WS_WBR) + (size_t)br * DM * DBR, DBR); continue; }
        q -= T_BR;
        if (q < T_OUT) { const int kt = q & 31, ntl = q >> 5; tconv_tile(tile, P.in[24] + (size_t)l * DM * DM, DM, kt * 64, ntl * 64, 0, (bf16_t*)(ws + WS_WOUT), DM); continue; }
        q -= T_OUT;
        if (q < T_MEM) { const int kt = q & 31, ntl = q >> 5; tconv_tile(tile, P.in[22] + (size_t)l * DM * DM, DM, kt * 64, ntl * 64, 0, (bf16_t*)(ws + WS_WMEM), DM); continue; }
        q -= T_MEM;
        if (q < T_W1) { const int kv = q >> 7, r = q & 127, kt = r & 31, ntl = r >> 5;
            tconv_tile(tile, P.in[17 + kv] + (size_t)l * 2048 * 256, 256, kt * 64, ntl * 64, 0, (bf16_t*)(ws + WS_W1T) + (size_t)kv * 256 * 2048, 2048); continue; }
        q -= T_W1;
        { const int mat = q >> 5, r = q & 31, n = r >> 2, kt = r & 1, ntl = (r >> 1) & 1;
            tconv_tile(tile, P.in[mat ? 12 : 10] + ((size_t)l * 8 + n) * 128 * 128, 128, kt * 64, ntl * 64, 0, (bf16_t*)(ws + WS_WAT) + ((size_t)mat * 8 + n) * 128 * 128, 128); }
    }
    const size_t gtid = (size_t)blockIdx.x * 512 + tid, gstride = (size_t)G * 512;
    { const float* sw = P.in[6] + (size_t)l * 8 * 128 * 128; bf16_t* d = (bf16_t*)(ws + WS_SGW);
        for (size_t i = gtid; i < (size_t)8 * 128 * 128 / 2; i += gstride) { const size_t e = i * 2; const int s = (int)(e & 127), t = (int)((e >> 7) & 127);
            const float a = (s <= t) ? sw[e] : 0.f, b = (s + 1 <= t) ? sw[e + 1] : 0.f; ((unsigned*)d)[i] = cvt_pk_bf16(a, b); } }
    for (int u = blockIdx.x; u < 8; u += G) { const int kv = u >> 2, cb = u & 3, col = cb * 64 + (tid & 63), ks = tid >> 6;
        const float* pe = P.in[15 + kv] + (size_t)l * 2048; const float* w1 = P.in[17 + kv] + (size_t)l * 2048 * 256; float s = 0.f;
        for (int k = ks * 256; k < ks * 256 + 256; ++k) s += pe[k] * w1[(size_t)k * 256 + col];
        tile[tid] = s; __syncthreads();
        if (tid < 64) { float a = 0.f;
#pragma unroll
            for (int j = 0; j < 8; ++j) a += tile[j * 64 + tid];
            ((float*)(ws + WS_PEW1))[kv * 256 + col] = a; }
        __syncthreads(); }
    { const float* lam = P.in[14] + (size_t)l * DBR; float* sp8 = (float*)(ws + WS_PEW1) + 512;
        for (size_t i = gtid; i < (size_t)DBR; i += gstride) sp8[i] = 8.0f * log1pf(expf(-lam[i])); }
    if (l == 0) {
        { const f32x4* x = (const f32x4*)P.in[0]; u32x2* d = (u32x2*)(ws + WS_XB);
            for (size_t i = gtid; i < (size_t)MT * DM / 4; i += 4 * gstride) { f32x4 v[4];
#pragma unroll
                for (int k = 0; k < 4; ++k) { const size_t j = i + k * gstride; v[k] = (j < (size_t)MT * DM / 4) ? x[j] : (f32x4){0.f, 0.f, 0.f, 0.f}; }
#pragma unroll
                for (int k = 0; k < 4; ++k) { const size_t j = i + k * gstride; if (j < (size_t)MT * DM / 4) { u32x2 w; w.x = cvt_pk_bf16(v[k][0], v[k][1]); w.y = cvt_pk_bf16(v[k][2], v[k][3]); d[j] = w; } } } }
        { const f32x4* x = (const f32x4*)P.in[1]; u32x2* d = (u32x2*)(ws + WS_MEMB);
            for (size_t i = gtid; i < (size_t)1024 * DM / 4; i += gstride) { const f32x4 v = x[i]; u32x2 w; w.x = cvt_pk_bf16(v[0], v[1]); w.y = cvt_pk_bf16(v[2], v[3]); d[i] = w; } }
        { float* lut = (float*)(ws + WS_LUT); const float* rb = P.in[2];
            for (size_t i = gtid; i < (size_t)16 * 4096; i += gstride) { const int h = (int)(i >> 12), dist = (int)(i & 4095); lut[i] = rb[rel_bucket(dist) * 16 + h] * LOG2E; } }
    }
}

template <int D, class SF>
__device__ __forceinline__ void attn_step(const bf16x8 (&qf)[D / 32], const LAS bf16_t* Ks, const LAS bf16_t* Vt, f32x4 (&o)[D / 16], float& m, float& lsum, float& alpha_out, bf16x8& pf0_out, bf16x8& pf1_out, const int lane, SF sf) {
    constexpr int KSTR = D + 8;
    const int c = lane & 15, i = lane >> 4;
    f32x4 s[4];
#pragma unroll
    for (int t = 0; t < 4; ++t) s[t] = (f32x4){0.f, 0.f, 0.f, 0.f};
#pragma unroll
    for (int ks = 0; ks < D / 32; ++ks) {
#pragma unroll
        for (int t = 0; t < 4; ++t) { const bf16x8 kf = *(const LAS bf16x8*)(Ks + (16 * t + c) * KSTR + ks * 32 + 8 * i); s[t] = mfma16(kf, qf[ks], s[t]); }
    }
    float v[16];
#pragma unroll
    for (int t = 0; t < 4; ++t)
#pragma unroll
        for (int r = 0; r < 4; ++r) v[4 * t + r] = sf(16 * t + 4 * i + r, s[t][r]);
    float mx = fmaxf(fmaxf(fmaxf(v[0], v[1]), fmaxf(v[2], v[3])), fmaxf(fmaxf(v[4], v[5]), fmaxf(v[6], v[7])));
    mx = fmaxf(mx, fmaxf(fmaxf(fmaxf(v[8], v[9]), fmaxf(v[10], v[11])), fmaxf(fmaxf(v[12], v[13]), fmaxf(v[14], v[15]))));
    mx = rows_max(mx);
    const float mnew = fmaxf(m, mx);
    const float mc = fmaxf(mnew, -1e20f);
    const float alpha = __builtin_amdgcn_exp2f(fmaxf(m, -1e20f) - mc);
    float p[16], rs = 0.f;
#pragma unroll
    for (int r = 0; r < 16; ++r) { p[r] = __builtin_amdgcn_exp2f(v[r] - mc); rs += p[r]; }
    rs = rows_sum(rs);
    lsum = lsum * alpha + rs; m = mnew;
    union { u32x4 u; bf16x8 b; } pk0, pk1;
    pk0.u.x = cvt_pk_bf16(p[0], p[1]); pk0.u.y = cvt_pk_bf16(p[2], p[3]); pk0.u.z = cvt_pk_bf16(p[4], p[5]); pk0.u.w = cvt_pk_bf16(p[6], p[7]);
    pk1.u.x = cvt_pk_bf16(p[8], p[9]); pk1.u.y = cvt_pk_bf16(p[10], p[11]); pk1.u.z = cvt_pk_bf16(p[12], p[13]); pk1.u.w = cvt_pk_bf16(p[14], p[15]);
    if (__builtin_amdgcn_ballot_w64(alpha != 1.0f) != 0ull) {
#pragma unroll
        for (int dt = 0; dt < D / 16; ++dt) o[dt] *= alpha;
    }
#pragma unroll
    for (int dt = 0; dt < D / 16; ++dt) {
        const LAS bf16_t* vp = Vt + (16 * dt + c) * 72 + 4 * i;
        union { u32x4 u; bf16x8 b; } vf0, vf1; const u32x2 a0 = *(const LAS u32x2*)vp, a1 = *(const LAS u32x2*)(vp + 16), b0 = *(const LAS u32x2*)(vp + 32), b1 = *(const LAS u32x2*)(vp + 48);
        vf0.u.x = a0.x; vf0.u.y = a0.y; vf0.u.z = a1.x; vf0.u.w = a1.y; vf1.u.x = b0.x; vf1.u.y = b0.y; vf1.u.z = b1.x; vf1.u.w = b1.y;
        o[dt] = mfma16(vf0.b, pk0.b, o[dt]); o[dt] = mfma16(vf1.b, pk1.b, o[dt]);
    }
    alpha_out = alpha; pf0_out = pk0.b; pf1_out = pk1.b;
}
template <int D>
__device__ __forceinline__ void load_k_tile(const int tid, LAS bf16_t* Ks, const bf16_t* src, size_t ld, int p0, int pmax) {
#pragma unroll
    for (int it = 0; it < D / 64; ++it) { const int idx = tid + it * 512, key = idx & 63, seg = idx >> 6, p = p0 + key;
        u32x4 v = (u32x4){0u, 0u, 0u, 0u}; if (p >= 0 && p <= pmax) v = *(const u32x4*)(src + (size_t)p * ld + seg * 8);
        *(LAS u32x4*)(Ks + key * (D + 8) + seg * 8) = v; }
}
template <int D>
__device__ __forceinline__ void load_vt_tile(const int tid, LAS bf16_t* Vt, const bf16_t* src, size_t ld, int p0, int pmax) {
#pragma unroll
    for (int it = 0; it < D / 64; ++it) { const int idx = tid + it * 512, key = idx & 63, seg = idx >> 6, p = p0 + key;
        u32x4 v = (u32x4){0u, 0u, 0u, 0u}; if (p >= 0 && p <= pmax) v = *(const u32x4*)(src + (size_t)p * ld + seg * 8);
        LAS bf16_t* d = Vt + (seg * 8) * 72 + key;
        d[0 * 72] = (bf16_t)(v.x & 0xffffu); d[1 * 72] = (bf16_t)(v.x >> 16); d[2 * 72] = (bf16_t)(v.y & 0xffffu); d[3 * 72] = (bf16_t)(v.y >> 16);
        d[4 * 72] = (bf16_t)(v.z & 0xffffu); d[5 * 72] = (bf16_t)(v.z >> 16); d[6 * 72] = (bf16_t)(v.w & 0xffffu); d[7 * 72] = (bf16_t)(v.w >> 16); }
}
__device__ __forceinline__ bf16x8 load_q_scaled(const bf16_t* p, float scale) {
    const u32x4 r = *(const u32x4*)p; union { u32x4 u; bf16x8 b; } q;
    q.u.x = cvt_pk_bf16(bflo(r.x) * scale, bfhi(r.x) * scale); q.u.y = cvt_pk_bf16(bflo(r.y) * scale, bfhi(r.y) * scale);
    q.u.z = cvt_pk_bf16(bflo(r.z) * scale, bfhi(r.z) * scale); q.u.w = cvt_pk_bf16(bflo(r.w) * scale, bfhi(r.w) * scale); return q.b;
}

__device__ __forceinline__ void memattn_unit(LAS unsigned char* lds, const Ctx& P, int unit) {
    const bf16_t* H = (const bf16_t*)(P.ws + WS_H); const bf16_t* MKV = (const bf16_t*)(P.ws + WS_MKV); bf16_t* O = (bf16_t*)(P.ws + WS_O) + (size_t)3 * MT * DBR;
    LAS bf16_t* Ks = (LAS bf16_t*)lds; LAS bf16_t* Vt = (LAS bf16_t*)(lds + 64 * 264 * 2);
    const int tb = unit & 31, head = (unit >> 5) & 3, b = unit >> 7;
    const int tid = opaque_tid(), wid = tid >> 6, lane = tid & 63, c = lane & 15, i = lane >> 4;
    const size_t tok = (size_t)b * SEQ + tb * 128 + wid * 16 + c;
    bf16x8 qf[8];
#pragma unroll
    for (int ks = 0; ks < 8; ++ks) qf[ks] = load_q_scaled(H + tok * LDH + C_QM + head * 256 + ks * 32 + 8 * i, 0.0625f);
    f32x4 o[16];
#pragma unroll
    for (int dt = 0; dt < 16; ++dt) o[dt] = (f32x4){0.f, 0.f, 0.f, 0.f};
    float m = NEGBIG, lsum = 0.f, alpha; bf16x8 pf, pf1;
    const bf16_t* kb = MKV + (size_t)b * 256 * DM + head * 256; const bf16_t* vb = kb + 1024;
    for (int kt = 0; kt < 4; ++kt) {
        __syncthreads();
        { u32x4 kr[4], vr[4];
#pragma unroll
            for (int it = 0; it < 4; ++it) { const int idx = tid + it * 512, key = idx & 63, seg = idx >> 6; const size_t off = (size_t)(kt * 64 + key) * DM + seg * 8; kr[it] = *(const u32x4*)(kb + off); vr[it] = *(const u32x4*)(vb + off); }
#pragma unroll
            for (int it = 0; it < 4; ++it) { const int idx = tid + it * 512, key = idx & 63, seg = idx >> 6; *(LAS u32x4*)(Ks + key * 264 + seg * 8) = kr[it];
                LAS bf16_t* d = Vt + (seg * 8) * 72 + key; const u32x4 v = vr[it];
                d[0 * 72] = (bf16_t)(v.x & 0xffffu); d[1 * 72] = (bf16_t)(v.x >> 16); d[2 * 72] = (bf16_t)(v.y & 0xffffu); d[3 * 72] = (bf16_t)(v.y >> 16);
                d[4 * 72] = (bf16_t)(v.z & 0xffffu); d[5 * 72] = (bf16_t)(v.z >> 16); d[6 * 72] = (bf16_t)(v.w & 0xffffu); d[7 * 72] = (bf16_t)(v.w >> 16); } }
        __syncthreads();
        attn_step<256>(qf, Ks, Vt, o, m, lsum, alpha, pf, pf1, lane, [](int, float s) { return s * LOG2E; });
    }
    const float inv = 1.0f / fmaxf(lsum, 1e-30f);
#pragma unroll
    for (int dt = 0; dt < 16; ++dt) { const int d0 = 16 * dt + 4 * i; const u32x2 g = *(const u32x2*)(H + tok * LDH + C_GM + head * 256 + d0);
        u32x2 w; w.x = cvt_pk_bf16(o[dt][0] * inv * bflo(g.x), o[dt][1] * inv * bfhi(g.x)); w.y = cvt_pk_bf16(o[dt][2] * inv * bflo(g.y), o[dt][3] * inv * bfhi(g.y));
        *(u32x2*)(O + tok * DBR + head * 256 + d0) = w; }
}

constexpr int NSA_LUT = 0  , NSA_KV = 16384  , NSA_IMP = NSA_KV + 36864  , NSA_SEL = NSA_IMP + 65536;
struct TileRegs { u32x4 k, v; };
__device__ __forceinline__ void tile_issue(TileRegs& r, const int tid, const bf16_t* ksrc, const bf16_t* vsrc, size_t ld, int p0, int pmax) {
    const int kkey = tid >> 3, kseg = tid & 7, pk = p0 + kkey; const int vkey = tid & 63, vseg = tid >> 6, pv = p0 + vkey;
    r.k = (u32x4){0u, 0u, 0u, 0u}; r.v = (u32x4){0u, 0u, 0u, 0u};
    if (pk >= 0 && pk <= pmax) r.k = *(const u32x4*)(ksrc + (size_t)pk * ld + kseg * 8);
    if (pv >= 0 && pv <= pmax) r.v = *(const u32x4*)(vsrc + (size_t)pv * ld + vseg * 8); }
__device__ __forceinline__ void tile_commit(const TileRegs& r, const int tid, LAS bf16_t* Ks, LAS bf16_t* Vt) {
    { const int key = tid >> 3, seg = tid & 7; *(LAS u32x4*)(Ks + key * 72 + seg * 8) = r.k; }
    const int key = tid & 63, seg = tid >> 6;
    LAS bf16_t* d = Vt + (seg * 8) * 72 + key; const u32x4 v = r.v;
    d[0 * 72] = (bf16_t)(v.x & 0xffffu); d[1 * 72] = (bf16_t)(v.x >> 16); d[2 * 72] = (bf16_t)(v.y & 0xffffu); d[3 * 72] = (bf16_t)(v.y >> 16);
    d[4 * 72] = (bf16_t)(v.z & 0xffffu); d[5 * 72] = (bf16_t)(v.z >> 16); d[6 * 72] = (bf16_t)(v.w & 0xffffu); d[7 * 72] = (bf16_t)(v.w >> 16); }
__device__ __forceinline__ void nsa_unit(LAS unsigned char* lds, const Ctx& P, int l, int b, int hkv, int tb) {
    const bf16_t* H = (const bf16_t*)(P.ws + WS_H); bf16_t* O = (bf16_t*)(P.ws + WS_O) + (size_t)2 * MT * DBR;
    const bf16_t* KC = (const bf16_t*)(P.ws + WS_KCV) + (size_t)((b * 4 + hkv) * 256) * 64; const bf16_t* VC = KC + (size_t)4096 * 64;
    LAS bf16_t* KV = (LAS bf16_t*)(lds + NSA_KV);
    LAS float* impb = (LAS float*)(lds + NSA_IMP); LAS unsigned long long* sels = (LAS unsigned long long*)(lds + NSA_SEL);
    const int tid = opaque_tid(), wid = tid >> 6, lane = tid & 63, c = lane & 15, i = lane >> 4, g = wid & 3, th = wid >> 2, hq = hkv * 4 + g;
    const LAS float* lut = (const LAS float*)(lds + NSA_LUT) + g * 1024;
    const int t0 = tb * 64, qb = tb;
    int tq[2]; size_t tok[2];
#pragma unroll
    for (int sb = 0; sb < 2; ++sb) { tq[sb] = t0 + 32 * th + 16 * sb + c; tok[sb] = (size_t)b * SEQ + tq[sb]; }
    bf16x8 qf[2][2];
#pragma unroll
    for (int sb = 0; sb < 2; ++sb)
#pragma unroll
        for (int ks = 0; ks < 2; ++ks) qf[sb][ks] = load_q_scaled(H + tok[sb] * LDH + C_Q + hq * 64 + ks * 32 + 8 * i, 0.125f);
    f32x4* park = (f32x4*)(P.ws + WS_PARK) + ((size_t)(blockIdx.x * 8 + wid) * 8) * 64 + lane;
    float alpha; bf16x8 pf, pf1;
    auto load2 = [&](const bf16_t* ksrc, const bf16_t* vsrc, size_t ld, int p0a, int p0b, bool hasb, int pmax) {
        TileRegs ra, rb; tile_issue(ra, tid, ksrc, vsrc, ld, p0a, pmax); if (hasb) tile_issue(rb, tid, ksrc, vsrc, ld, p0b, pmax);
        tile_commit(ra, tid, KV, KV + 4608); if (hasb) tile_commit(rb, tid, KV + 9216, KV + 9216 + 4608); };
#pragma unroll 1
    for (int sb = 0; sb < 2; ++sb) {
        f32x4 o[4], oi[4]; float m = NEGBIG, lsum = 0.f;
#pragma unroll
        for (int dt = 0; dt < 4; ++dt) { o[dt] = (f32x4){0.f, 0.f, 0.f, 0.f}; oi[dt] = (f32x4){0.f, 0.f, 0.f, 0.f}; }
        bf16x8 ovA[2], ovB[2];
#pragma unroll
        for (int st = 0; st < 2; ++st)
#pragma unroll
            for (int j = 0; j < 8; ++j) { const int nl = 32 * st + (j < 4 ? 4 * i + j : 16 + 4 * i + (j - 4));
                float a = 0.f; if ((nl >> 2) == c) a = ((nl & 3) == 3) ? 0.5f : 1.0f; else if ((nl >> 2) == c - 1 && (nl & 3) == 3) a = 0.5f;
                const float bb = (c == 0 && nl == 63) ? 0.5f : 0.f;
                ovA[st][j] = (short)(__float_as_uint(a) >> 16); ovB[st][j] = (short)(__float_as_uint(bb) >> 16); }
        const int ntile = ((t0 >> 4) + 2) / 64 + 1;
        const int tqs = t0 + 32 * th + 16 * sb + c;
        bf16x8 qs[2];
#pragma unroll
        for (int ks = 0; ks < 2; ++ks) qs[ks] = load_q_scaled(H + ((size_t)b * SEQ + tqs) * LDH + C_Q + hq * 64 + ks * 32 + 8 * i, 0.125f);
#pragma unroll
        for (int pr = 0; pr < 2; ++pr) if (2 * pr < ntile) {
            const bool hasb = 2 * pr + 1 < ntile;
            __syncthreads();
            load2(KC, VC, 64, 128 * pr, 128 * pr + 64, hasb, 255);
            __syncthreads();
#pragma unroll
            for (int sl = 0; sl < 2; ++sl) if (sl == 0 || hasb) {
                const int kt = 2 * pr + sl; const LAS bf16_t* Ks = KV + sl * 9216; const LAS bf16_t* Vt = Ks + 4608; const int nb = kt * 64;
                attn_step<64>(qs, Ks, Vt, o, m, lsum, alpha, pf, pf1, lane,
                    [&](int kk, float s) { const int dist = tqs - (16 * (nb + kk) + 31); return dist >= 0 ? s * LOG2E + lut[min((unsigned)dist, 1023u)] : NEGBIG; });
#pragma unroll
                for (int jt = 0; jt < 4; ++jt) oi[jt] *= alpha;
                oi[kt] = mfma16(ovA[0], pf, oi[kt]); oi[kt] = mfma16(ovA[1], pf1, oi[kt]);
                if (kt + 1 < 4) { oi[kt + 1 < 4 ? kt + 1 : 3] = mfma16(ovB[0], pf, oi[kt + 1 < 4 ? kt + 1 : 3]); oi[kt + 1 < 4 ? kt + 1 : 3] = mfma16(ovB[1], pf1, oi[kt + 1 < 4 ? kt + 1 : 3]); }
            }
        }
        const float inv = 1.0f / fmaxf(lsum, 1e-30f);
        const float g0 = sigmoidf_(bf2f(H[((size_t)b * SEQ + tqs) * LDH + C_GL + hq]) + P.in[21][l * 48 + hq]) * inv;
#pragma unroll
        for (int dt = 0; dt < 4; ++dt) { park[(sb * 4 + dt) * 64] = o[dt] * g0;
            *(LAS f32x4*)(impb + (g * 64 + 32 * th + 16 * sb + c) * 64 + 16 * dt + 4 * i) = oi[dt] * inv; }
    }
    __syncthreads();
    {
#pragma unroll
        for (int tt = 0; tt < 8; ++tt) { const int tl = 8 * wid + tt;
            unsigned long long mask;
            if (qb <= 7) mask = (2ull << qb) - 1ull;
            else {
                const float v = impb[(0 * 64 + tl) * 64 + lane] + impb[(1 * 64 + tl) * 64 + lane] + impb[(2 * 64 + tl) * 64 + lane] + impb[(3 * 64 + tl) * 64 + lane];
                float vv = (lane >= 1 && lane <= qb - 2) ? v : -__builtin_inff();
                mask = 1ull | (1ull << qb) | (1ull << (qb - 1));
#pragma unroll
                for (int r = 0; r < 5; ++r) { const float mx = wave_max(vv); const unsigned long long bal = __ballot(vv == mx);
                    const int js = __builtin_ctzll(bal); mask |= 1ull << js; if (lane == js) vv = -__builtin_inff(); }
            }
            if (lane == 0) sels[tl] = mask; }
    }
    __syncthreads();
    {
        unsigned long long ms[2]; unsigned long long U = 0ull;
#pragma unroll
        for (int sb = 0; sb < 2; ++sb) ms[sb] = sels[32 * th + 16 * sb + c];
        for (int t = 0; t < 64; ++t) U |= sels[t];
        f32x4 o[2][4]; float m[2], lsum[2];
#pragma unroll
        for (int sb = 0; sb < 2; ++sb) { m[sb] = NEGBIG; lsum[sb] = 0.f;
#pragma unroll
            for (int dt = 0; dt < 4; ++dt) o[sb][dt] = (f32x4){0.f, 0.f, 0.f, 0.f}; }
        const bf16_t* kb = H + (size_t)b * SEQ * LDH + C_KS + hkv * 64; const bf16_t* vb = H + (size_t)b * SEQ * LDH + C_VS + hkv * 64;
        U &= ((2ull << qb) - 1ull);
        unsigned long long Ur = ((unsigned long long)(unsigned)__builtin_amdgcn_readfirstlane((int)(U >> 32)) << 32) | (unsigned)__builtin_amdgcn_readfirstlane((int)U);
        const float cfar = lut[790];
        while (Ur != 0ull) {
            const int ja = __builtin_ctzll(Ur); Ur &= Ur - 1ull; const bool hasb = Ur != 0ull; int jb = 0; if (hasb) { jb = __builtin_ctzll(Ur); Ur &= Ur - 1ull; }
            __syncthreads();
            load2(kb, vb, LDH, ja * 64, jb * 64, hasb, SEQ - 1);
            __syncthreads();
#pragma unroll
            for (int sl = 0; sl < 2; ++sl) if (sl == 0 || hasb) {
                const int j = sl ? jb : ja; const LAS bf16_t* Ks = KV + sl * 9216; const LAS bf16_t* Vt = Ks + 4608;
                const bool far = t0 - (64 * j + 63) >= 790;
#pragma unroll
                for (int sb = 0; sb < 2; ++sb) { const bool selj = (ms[sb] >> j) & 1ull; const int tqs = tq[sb];
                    if (far) {
                        if (__builtin_amdgcn_ballot_w64(selj) == 0ull) continue;
                        attn_step<64>(qf[sb], Ks, Vt, o[sb], m[sb], lsum[sb], alpha, pf, pf1, lane,
                            [&](int, float s) { return selj ? s * LOG2E + cfar : NEGBIG; });
                    } else { const int kp0 = j * 64;
                        attn_step<64>(qf[sb], Ks, Vt, o[sb], m[sb], lsum[sb], alpha, pf, pf1, lane,
                            [&](int kk, float s) { const int dist = tqs - (kp0 + kk); return (selj && dist >= 0) ? s * LOG2E + lut[min((unsigned)dist, 1023u)] : NEGBIG; });
                    }
                }
            }
        }
#pragma unroll
        for (int sb = 0; sb < 2; ++sb) { const float g1 = sigmoidf_(bf2f(H[tok[sb] * LDH + C_GL + 16 + hq]) + P.in[21][l * 48 + 16 + hq]) / fmaxf(lsum[sb], 1e-30f);
#pragma unroll
            for (int dt = 0; dt < 4; ++dt) park[(sb * 4 + dt) * 64] += o[sb][dt] * g1; }
    }
    {
        f32x4 o[2][4]; float m[2], lsum[2];
#pragma unroll
        for (int sb = 0; sb < 2; ++sb) { m[sb] = NEGBIG; lsum[sb] = 0.f;
#pragma unroll
            for (int dt = 0; dt < 4; ++dt) o[sb][dt] = (f32x4){0.f, 0.f, 0.f, 0.f}; }
        const bf16_t* kb = H + (size_t)b * SEQ * LDH + C_KW + hkv * 64; const bf16_t* vb = H + (size_t)b * SEQ * LDH + C_VW + hkv * 64;
        const int kfirst = (t0 >= 256) ? 0 : (256 - t0) / 64;
        for (int k = kfirst; k < 5; k += 2) { const int p0 = t0 - 256 + 64 * k; const bool hasb = k + 1 < 5;
            __syncthreads();
            load2(kb, vb, LDH, p0, p0 + 64, hasb, SEQ - 1);
            __syncthreads();
#pragma unroll
            for (int sl = 0; sl < 2; ++sl) if (sl == 0 || hasb) { const LAS bf16_t* Ks = KV + sl * 9216; const LAS bf16_t* Vt = Ks + 4608; const int kp0 = p0 + sl * 64;
#pragma unroll
                for (int sb = 0; sb < 2; ++sb) { const int tqs = tq[sb];
                    attn_step<64>(qf[sb], Ks, Vt, o[sb], m[sb], lsum[sb], alpha, pf, pf1, lane,
                        [&](int kk, float s) { const int kpos = kp0 + kk, dist = tqs - kpos; return (dist >= 0 && dist < 256 && kpos >= 0) ? s * LOG2E + lut[min((unsigned)dist, 1023u)] : NEGBIG; }); }
            }
        }
#pragma unroll
        for (int sb = 0; sb < 2; ++sb) { const float g2 = sigmoidf_(bf2f(H[tok[sb] * LDH + C_GL + 32 + hq]) + P.in[21][l * 48 + 32 + hq]) / fmaxf(lsum[sb], 1e-30f);
#pragma unroll
            for (int dt = 0; dt < 4; ++dt) { const f32x4 r = park[(sb * 4 + dt) * 64] + o[sb][dt] * g2;
                const int d0 = 16 * dt + 4 * i; const u32x2 gg = *(const u32x2*)(H + tok[sb] * LDH + C_GC + hq * 64 + d0);
                u32x2 w; w.x = cvt_pk_bf16(r[0] * bflo(gg.x), r[1] * bfhi(gg.x)); w.y = cvt_pk_bf16(r[2] * bflo(gg.y), r[3] * bfhi(gg.y));
                *(u32x2*)(O + tok[sb] * DBR + hq * 64 + d0) = w; } }
    }
}

__device__ __forceinline__ void gmlp_unit(LAS unsigned char* lds, const Ctx& P, int l, int unit) {
    const bf16_t* H = (const bf16_t*)(P.ws + WS_H); const bf16_t* SGW = (const bf16_t*)(P.ws + WS_SGW); bf16_t* O = (bf16_t*)(P.ws + WS_O);
    const float* lng = P.in[4] + l * DBR; const float* lnb = P.in[5] + l * DBR; const float* sgb = P.in[7] + l * 8 * 128;
    LAS float* stats = (LAS float*)lds; LAS bf16_t* vT = (LAS bf16_t*)(lds + 1024);
    const int hf = unit & 1, bc = unit >> 1; const size_t tok0 = (size_t)bc * 128;
    const int tid = opaque_tid(), wid = tid >> 6, lane = tid & 63, c = lane & 15, i = lane >> 4;
    __syncthreads();
#pragma unroll 2
    for (int r = 0; r < 16; ++r) { const int t = wid * 16 + r; const bf16_t* row = H + (tok0 + t) * LDH + C_V;
        const u32x4 a = *(const u32x4*)(row + lane * 8), bb = *(const u32x4*)(row + 512 + lane * 8);
        const float x[16] = {bflo(a.x), bfhi(a.x), bflo(a.y), bfhi(a.y), bflo(a.z), bfhi(a.z), bflo(a.w), bfhi(a.w), bflo(bb.x), bfhi(bb.x), bflo(bb.y), bfhi(bb.y), bflo(bb.z), bfhi(bb.z), bflo(bb.w), bfhi(bb.w)};
        float s = 0.f;
#pragma unroll
        for (int e = 0; e < 16; ++e) s += x[e];
        const float mean = wave_sum(s) * (1.0f / 1024.0f); float q = 0.f;
#pragma unroll
        for (int e = 0; e < 16; ++e) q += (x[e] - mean) * (x[e] - mean);
        const float var = wave_sum(q) * (1.0f / 1024.0f);
        if (lane == 0) { stats[2 * t] = mean; stats[2 * t + 1] = rsqrtf(var + 1e-5f); } }
    __syncthreads();
    for (int gi = 0; gi < 4; ++gi) { const int g = hf * 4 + gi;
        { const int s = tid >> 2, dseg = tid & 3; const float mean = stats[2 * s], rstd = stats[2 * s + 1];
            const bf16_t* row = H + (tok0 + s) * LDH + C_V + g * 128 + dseg * 32;
#pragma unroll
            for (int q4 = 0; q4 < 4; ++q4) { const u32x4 w = *(const u32x4*)(row + q4 * 8);
                const float x[8] = {bflo(w.x), bfhi(w.x), bflo(w.y), bfhi(w.y), bflo(w.z), bfhi(w.z), bflo(w.w), bfhi(w.w)};
                const int chb = g * 128 + dseg * 32 + q4 * 8; const f32x4 g0 = *(const f32x4*)(lng + chb), g1 = *(const f32x4*)(lng + chb + 4), b0 = *(const f32x4*)(lnb + chb), b1 = *(const f32x4*)(lnb + chb + 4);
#pragma unroll
                for (int e = 0; e < 8; ++e) { const int d = dseg * 32 + q4 * 8 + e;
                    const float val = (x[e] - mean) * rstd * (e < 4 ? g0[e & 3] : g1[e & 3]) + (e < 4 ? b0[e & 3] : b1[e & 3]); vT[d * 136 + s] = (bf16_t)(cvt_pk_bf16(val, 0.f) & 0xffffu); } } }
        __syncthreads();
        f32x4 acc[8];
#pragma unroll
        for (int nt = 0; nt < 8; ++nt) acc[nt] = (f32x4){0.f, 0.f, 0.f, 0.f};
        const int nks = (16 * wid + 15) / 32 + 1;
        for (int ks = 0; ks < nks; ++ks) { const bf16x8 wf = *(const bf16x8*)(SGW + ((size_t)(g * 128 + 16 * wid + c)) * 128 + ks * 32 + 8 * i);
#pragma unroll
            for (int nt = 0; nt < 8; ++nt) { const bf16x8 vf = *(const LAS bf16x8*)(vT + (16 * nt + c) * 136 + ks * 32 + 8 * i); acc[nt] = mfma16(vf, wf, acc[nt]); } }
        { const int t = 16 * wid + c; const size_t tok = tok0 + t; const float bs = sgb[g * 128 + t];
#pragma unroll
            for (int nt = 0; nt < 8; ++nt) { const int ch0 = g * 128 + 16 * nt + 4 * i;
                const u32x2 uu = *(const u32x2*)(H + tok * LDH + C_U + ch0), gg = *(const u32x2*)(H + tok * LDH + C_GA + ch0);
                u32x2 w; w.x = cvt_pk_bf16((acc[nt][0] + bs) * bflo(uu.x) * bflo(gg.x), (acc[nt][1] + bs) * bfhi(uu.x) * bfhi(gg.x));
                w.y = cvt_pk_bf16((acc[nt][2] + bs) * bflo(uu.y) * bflo(gg.y), (acc[nt][3] + bs) * bfhi(uu.y) * bfhi(gg.y));
                *(u32x2*)(O + tok * DBR + ch0) = w; } }
        __syncthreads();
    }
}

__device__ __forceinline__ void lru_a_unit(LAS unsigned char* lds, const Ctx& P, int l, int unit) {
    const bf16_t* H = (const bf16_t*)(P.ws + WS_H); const bf16_t* WAT = (const bf16_t*)(P.ws + WS_WAT);
    unsigned* LRW = (unsigned*)(P.ws + WS_LRA);
    const float* cw = P.in[8] + l * 4 * DBR; const float* cb = P.in[9] + l * DBR; const float* ba = P.in[11] + l * DBR; const float* bx = P.in[13] + l * DBR; const float* SP8 = (const float*)(P.ws + WS_PEW1) + 512;
    LAS bf16_t* xc = (LAS bf16_t*)lds; const LAS bf16_t* wl = (const LAS bf16_t*)(lds + 34816);
    const int n = unit & 7, bc = unit >> 3, b = bc >> 5, ck = bc & 31;
    const int tid = opaque_tid(), wid = tid >> 6, lane = tid & 63, c = lane & 15, i = lane >> 4;
    __syncthreads();
    { const int t = tid >> 2, dseg = tid & 3, pos = ck * 128 + t;
        u32x4 xr[4][4];
#pragma unroll
        for (int k = 0; k < 4; ++k) { const int pp = pos - 3 + k;
#pragma unroll
            for (int q4 = 0; q4 < 4; ++q4) { xr[k][q4] = (u32x4){0u, 0u, 0u, 0u};
                if (pp >= 0) xr[k][q4] = *(const u32x4*)(H + ((size_t)b * SEQ + pp) * LDH + C_XB + n * 128 + dseg * 32 + q4 * 8); } }
#pragma unroll
        for (int q4 = 0; q4 < 4; ++q4) { const int ch0 = n * 128 + dseg * 32 + q4 * 8; float a8[8];
            { const f32x4 c0 = *(const f32x4*)(cb + ch0), c1 = *(const f32x4*)(cb + ch0 + 4);
#pragma unroll
                for (int e = 0; e < 4; ++e) { a8[e] = c0[e]; a8[4 + e] = c1[e]; } }
#pragma unroll
            for (int k = 0; k < 4; ++k) { const u32x4 w = xr[k][q4];
                const f32x4 w0 = *(const f32x4*)(cw + k * DBR + ch0), w1 = *(const f32x4*)(cw + k * DBR + ch0 + 4);
                const float x[8] = {bflo(w.x), bfhi(w.x), bflo(w.y), bfhi(w.y), bflo(w.z), bfhi(w.z), bflo(w.w), bfhi(w.w)};
#pragma unroll
                for (int e = 0; e < 4; ++e) { a8[e] += w0[e] * x[e]; a8[4 + e] += w1[e] * x[4 + e]; } }
            u32x4 w; w.x = cvt_pk_bf16(a8[0], a8[1]); w.y = cvt_pk_bf16(a8[2], a8[3]); w.z = cvt_pk_bf16(a8[4], a8[5]); w.w = cvt_pk_bf16(a8[6], a8[7]);
            *(LAS u32x4*)(xc + t * 136 + dseg * 32 + q4 * 8) = w; } }
    __syncthreads();
    bf16x8 yf[4];
#pragma unroll
    for (int ks = 0; ks < 4; ++ks) yf[ks] = *(const LAS bf16x8*)(xc + (16 * wid + c) * 136 + ks * 32 + 8 * i);
    const int t = 16 * wid + c; const size_t tok = (size_t)bc * 128 + t;
#pragma unroll
    for (int nt = 0; nt < 8; ++nt) { f32x4 aA = (f32x4){0.f, 0.f, 0.f, 0.f}, aX = (f32x4){0.f, 0.f, 0.f, 0.f};
#pragma unroll
        for (int ks = 0; ks < 4; ++ks) { const bf16x8 wa = *(const LAS bf16x8*)(wl + (16 * nt + c) * 136 + ks * 32 + 8 * i);
            const bf16x8 wx = *(const LAS bf16x8*)(wl + (128 + 16 * nt + c) * 136 + ks * 32 + 8 * i);
            aA = mfma16(wa, yf[ks], aA); aX = mfma16(wx, yf[ks], aX); }
        const int e0 = 16 * nt + 4 * i, ch0 = n * 128 + e0; const u32x2 xw = *(const LAS u32x2*)(xc + t * 136 + e0);
        const float xv[4] = {bflo(xw.x), bfhi(xw.x), bflo(xw.y), bfhi(xw.y)}; f32x4 av, gv;
        const f32x4 bav = *(const f32x4*)(ba + ch0), bxv = *(const f32x4*)(bx + ch0), spv = *(const f32x4*)(SP8 + ch0);
#pragma unroll
        for (int r = 0; r < 4; ++r) { const float rr = sigmoidf_(aA[r] + bav[r]), ii = sigmoidf_(aX[r] + bxv[r]);
            const float a = __expf(-rr * spv[r]);
            av[r] = a; gv[r] = __builtin_amdgcn_sqrtf(fmaxf(1.0f - a * a, 0.f)) * ii * xv[r]; }
        u32x4 pw;
#pragma unroll
        for (int r = 0; r < 4; ++r) { const float am = fmaxf(1.0f - __expf(-spv[r]), 1e-30f);
            const unsigned q = (unsigned)fminf((1.0f - av[r]) * (65535.0f * __builtin_amdgcn_rcpf(am)) + 0.5f, 65535.0f); pw[r] = (cvt_pk_bf16(0.f, gv[r]) & 0xffff0000u) | q; }
        *(u32x4*)(LRW + tok * DBR + ch0) = pw; }
}

__device__ __forceinline__ void fast_sync(unsigned* ctl, unsigned gen, unsigned nwg) {
    __syncthreads();
    if (threadIdx.x == 0) {
        __builtin_amdgcn_fence(__ATOMIC_RELEASE, "agent");
        asm volatile("s_waitcnt vmcnt(0) lgkmcnt(0)" ::: "memory");
        bool last = false;
        if (__hip_atomic_fetch_add(ctl + 256 + 32 * (blockIdx.x & 7), 1u, __ATOMIC_RELAXED, __HIP_MEMORY_SCOPE_AGENT) == gen * (nwg >> 3) - 1u) {
            if (__hip_atomic_fetch_add(ctl, 1u, __ATOMIC_RELAXED, __HIP_MEMORY_SCOPE_AGENT) == gen * 8u - 1u) { __hip_atomic_store(ctl + 32, gen, __ATOMIC_RELAXED, __HIP_MEMORY_SCOPE_AGENT); last = true; } }
        if (!last) while (__hip_atomic_load(ctl + 32, __ATOMIC_RELAXED, __HIP_MEMORY_SCOPE_AGENT) < gen) __builtin_amdgcn_s_sleep(1);
        __builtin_amdgcn_fence(__ATOMIC_ACQUIRE, "agent");
        asm volatile("s_waitcnt vmcnt(0) lgkmcnt(0)" ::: "memory");
    }
    __syncthreads();
}

__global__ void __launch_bounds__(512, 2) fwd_megakernel(Params PK) {
    extern __shared__ __attribute__((aligned(16))) unsigned char lds_raw[];
    LAS unsigned char* lds = (LAS unsigned char*)lds_raw;
    cg::grid_group grid = cg::this_grid();
    LAS u64_t* pl = (LAS u64_t*)(lds + PL_OFF);
    if (threadIdx.x == 0) {
#pragma unroll
        for (int k = 0; k < 27; ++k) pl[k] = (u64_t)PK.in[k];
        pl[27] = (u64_t)PK.out; pl[28] = (u64_t)PK.ws; }
    __syncthreads();
    const int G = gridDim.x, bid = blockIdx.x;
    const size_t gstride = (size_t)G * 512;
    const int ph_lo = PK.ph_lo, ph_hi = PK.ph_hi;
    unsigned nbar = 0u;

    for (int gp = ph_lo; gp < ph_hi; ++gp) {
        const int tid = opaque_tid(); const size_t gtid = (size_t)bid * 512 + tid;
        asm volatile("" ::: "memory");
        Ctx P; P.in.pl = pl; P.out = (float*)P.in[27]; P.ws = (unsigned char*)P.in[28];
        unsigned char* ws = P.ws; bf16_t* Hh = (bf16_t*)(ws + WS_H);
        const int l = gp >= 9 ? 1 : 0; const int ph = gp == 0 ? 0 : (gp <= 8 ? gp : (gp == 16 ? 8 : gp - 8));
        if (gp == 0) prologue(lds, P, 0);
        else if (ph == 1) {
            { pg8::SchedStd S{64, 75, G, bid, DM, (const bf16_t*)(ws + (l == 0 ? WS_XB : WS_XB2)), (const bf16_t*)(ws + WS_WIN)}; pg8::EpiInProj E{Hh, ws + WS_G8}; pg8::gemm_phase(lds, DM, S, E); }
            { pg8::SchedStd S{4, 8, G, G - 1 - bid, DM, (const bf16_t*)(ws + WS_MEMB), (const bf16_t*)(ws + WS_WMEM)}; pg8::EpiBf16 E{(bf16_t*)(ws + WS_MKV), DM, 0, nullptr, 0, 0}; pg8::gemm_phase(lds, DM, S, E); }
        } else if (ph == 2) {
            for (int u = bid; u < 256; u += G) gmlp_unit(lds, P, l, u);
            { int cur_n = -1;
                for (int u = bid; u < 1024; u += G) { const int n = u & 7;
                    if (n != cur_n) { __syncthreads(); const bf16_t* WAT = (const bf16_t*)(ws + WS_WAT); LAS bf16_t* wl = (LAS bf16_t*)(lds + 34816);
                        for (int q = tid; q < 2 * 128 * 16; q += 512) { const int mat = q >> 11, r = (q >> 4) & 127, sg = q & 15;
                            *(LAS u32x4*)(wl + (mat * 128 + r) * 136 + sg * 8) = *(const u32x4*)(WAT + ((size_t)(mat * 8 + n) * 128 + r) * 128 + sg * 8); }
                        cur_n = n; __syncthreads(); }
                    lru_a_unit(lds, P, l, u); } }
            { bf16_t* A0 = (bf16_t*)(ws + WS_A0);
                for (size_t idx = gtid; idx < (size_t)2 * 4096 * 256; idx += gstride) { const int ch = (int)(idx & 255), row = (int)((idx >> 8) & 4095), kv = (int)(idx >> 20);
                    const int j = ch >> 3, d8 = (ch & 7) * 8, bh = row >> 8, n = row & 255, b = bh >> 2, hkv = bh & 3;
                    u32x4 v = (u32x4){0u, 0u, 0u, 0u};
                    if (n < 255) v = *(const u32x4*)(Hh + ((size_t)b * SEQ + 16 * n + j) * LDH + (kv ? C_VC : C_KC) + hkv * 64 + d8);
                    *(u32x4*)(A0 + ((size_t)kv * 4096 + row) * 2048 + j * 64 + d8) = v; } }
            __syncthreads();
            for (int u = bid; u < 512; u += G) memattn_unit(lds, P, u);
        } else if (ph == 3) {
            { const unsigned* LRW = (const unsigned*)(ws + WS_LRA); float* AGP = (float*)(ws + WS_AGG); float* AGH = AGP + 128 * 1024;
                for (size_t id = gtid; id < (size_t)128 * 1024; id += gstride) { const int ch = (int)(id & 1023), bc = (int)(id >> 10); const size_t base = (size_t)bc * 128 * DBR + ch;
                    float p = 1.f, h = 0.f; const float sc = fmaxf(1.0f - __expf(-((const float*)(ws + WS_PEW1))[512 + ch]), 1e-30f) * (1.0f / 65535.0f);
#pragma unroll 8
                    for (int t = 0; t < 128; ++t) { const unsigned w = LRW[base + (size_t)t * DBR]; const float a = 1.0f - (float)(w & 0xffffu) * sc, g = bfhi(w); p *= a; h = a * h + g; }
                    AGP[id] = p; AGH[id] = h; } }
            { pg8::SchedCmp1 S{bid, (const bf16_t*)(ws + WS_A0), (const bf16_t*)(ws + WS_W1T)}; pg8::EpiBf16 E{(bf16_t*)(ws + WS_HID), 256, (size_t)4096 * 256, (const float*)(ws + WS_PEW1), 256, 2}; pg8::gemm_phase(lds, 2048, S, E); }
        } else if (ph == 4) {
            { const unsigned* LRW = (const unsigned*)(ws + WS_LRA); const float* AGP = (const float*)(ws + WS_AGG); const float* AGH = AGP + 128 * 1024;
                bf16_t* Ob = (bf16_t*)(ws + WS_O) + (size_t)1 * MT * DBR;
                for (size_t id = gtid; id < (size_t)128 * 1024; id += gstride) { const int ch = (int)(id & 1023), bc = (int)(id >> 10), b = bc >> 5, ck = bc & 31; const size_t base = (size_t)bc * 128 * DBR + ch;
                    float h = 0.f; const float sc = fmaxf(1.0f - __expf(-((const float*)(ws + WS_PEW1))[512 + ch]), 1e-30f) * (1.0f / 65535.0f);
                    for (int j = 0; j < ck; ++j) { const size_t a = (size_t)(b * 32 + j) * 1024 + ch; h = AGP[a] * h + AGH[a]; }
#pragma unroll 8
                    for (int t = 0; t < 128; ++t) { const unsigned w = LRW[base + (size_t)t * DBR]; const float a = 1.0f - (float)(w & 0xffffu) * sc, g = bfhi(w); h = a * h + g;
                        const float sg = bf2f(Hh[((size_t)bc * 128 + t) * LDH + C_GB + ch]);
                        Ob[base + (size_t)t * DBR] = (bf16_t)(cvt_pk_bf16(h * sg, 0.f) & 0xffffu); } } }
            { const bf16_t* HID = (const bf16_t*)(ws + WS_HID); bf16_t* KCV = (bf16_t*)(ws + WS_KCV);
                for (size_t id = gtid; id < (size_t)2 * 4096 * 16; id += gstride) { const int e4 = (int)(id & 15) * 4, row = (int)((id >> 4) & 4095), kv = (int)(id >> 16);
                    const float* w2 = P.in[19 + kv] + (size_t)l * 256 * 64; const bf16_t* hr = HID + ((size_t)kv * 4096 + row) * 256; f32x4 a = (f32x4){0.f, 0.f, 0.f, 0.f};
#pragma unroll 8
                    for (int k = 0; k < 256; k += 2) { const unsigned hw = *(const unsigned*)(hr + k);
                        a += *(const f32x4*)(w2 + (size_t)k * 64 + e4) * bflo(hw); a += *(const f32x4*)(w2 + (size_t)(k + 1) * 64 + e4) * bfhi(hw); }
                    u32x2 w; w.x = cvt_pk_bf16(a[0], a[1]); w.y = cvt_pk_bf16(a[2], a[3]); *(u32x2*)(KCV + ((size_t)kv * 4096 + row) * 64 + e4) = w; } }
        } else if (ph == 5) {
            int cur_hkv = -1;
            for (int u = bid; u < 1024; u += G) { const int v = u & 255, k = u >> 8, x = v >> 4, b = (v >> 2) & 3, hkv = v & 3, tb = (k & 1) ? 16 * k + 15 - x : 16 * k + x;
                if (hkv != cur_hkv) { __syncthreads(); const float* src = (const float*)(ws + WS_LUT) + (size_t)hkv * 4 * 4096; LAS float* dst = (LAS float*)(lds + NSA_LUT);
                    for (int q = tid; q < 4096; q += 512) dst[q] = src[(q >> 10) * 4096 + (q & 1023)];
                    cur_hkv = hkv; __syncthreads(); }
                nsa_unit(lds, P, l, b, hkv, tb); }
        } else if (ph == 6) {
            pg8::SchedMerge S{G, bid, (const bf16_t*)(ws + WS_O), (const bf16_t*)(ws + WS_WBR)}; pg8::EpiMerge E{(bf16_t*)(ws + WS_XB), ws + WS_G8}; pg8::gemm_phase(lds, DBR, S, E);
        } else if (ph == 7) {
            pg8::SchedOut S{bid, (const bf16_t*)(ws + WS_XB), (const bf16_t*)(ws + WS_WOUT)};
            pg8::EpiOutLN E{l == 0 ? P.in[0] : (const float*)P.out, P.out, l == 0 ? (bf16_t*)(ws + WS_XB2) : (bf16_t*)nullptr, P.in[25] + l * DM, P.in[26] + l * DM,
                            (unsigned*)ws + 64 + l * 64, (unsigned long long*)(ws + WS_LNX), lds + 131072};
            pg8::gemm_phase(lds, DM, S, E);
        } else if (ph == 8) {
            if (l == 0) prologue(lds, P, 1);
        }
        if (gp + 1 < ph_hi) { if (gp == ph_lo) grid.sync(); else { ++nbar; fast_sync((unsigned*)ws, nbar, (unsigned)G); } }
    }
}

extern "C" void kernel_launch(void* const* d_in, const int* in_sizes, int n_in, void* d_out, int out_size, void* d_ws, size_t ws_size, hipStream_t stream) {
    static int grid_blocks = 0;
    if (grid_blocks == 0) {
        if (n_in != 27 || ws_size < WS_END) { fprintf(stderr, "kernel_launch: unexpected n_in %d or ws_size %zu (< %zu)\n", n_in, ws_size, (size_t)WS_END); grid_blocks = -1; return; }
        int dev = 0, cus = 0, per_cu = 0;
        hipGetDevice(&dev); hipDeviceGetAttribute(&cus, hipDeviceAttributeMultiprocessorCount, dev);
        if (hipFuncSetAttribute((const void*)fwd_megakernel, hipFuncAttributeMaxDynamicSharedMemorySize, LDS_BYTES) != hipSuccess) { fprintf(stderr, "kernel_launch: hipFuncSetAttribute failed\n"); grid_blocks = -1; return; }
        hipOccupancyMaxActiveBlocksPerMultiprocessor(&per_cu, (const void*)fwd_megakernel, 512, LDS_BYTES);
        (void)hipGetLastError();
        if (per_cu < 1) per_cu = 1;
        if (cus < 256) { fprintf(stderr, "kernel_launch: built for a 256-CU device (got %d CUs); nothing launched\n", cus); grid_blocks = -1; return; }
        grid_blocks = 256;
        fprintf(stderr, "kernel_launch: cus %d per_cu %d grid %d\n", cus, per_cu, grid_blocks);
    }
    if (grid_blocks < 0) return;
    if (hipMemsetAsync(d_ws, 0, 4096, stream) != hipSuccess) { fprintf(stderr, "kernel_launch: hipMemsetAsync failed\n"); return; }
    Params p{};
    for (int i = 0; i < 27; ++i) p.in[i] = (const float*)d_in[i];
    p.out = (float*)d_out; p.ws = (unsigned char*)d_ws; p.ph_lo = 0; p.ph_hi = 16;
    void* args[] = {&p};
    hipError_t e = hipLaunchCooperativeKernel((const void*)fwd_megakernel, dim3(grid_blocks), dim3(512), args, LDS_BYTES, stream);
    if (e != hipSuccess) fprintf(stderr, "cooperative launch failed: %s (grid %d)\n", hipGetErrorString(e), grid_blocks);
}
```

```cpp
#include <hip/hip_runtime.h>
#include <hip/hip_cooperative_groups.h>
#include <cstdio>
namespace cg = cooperative_groups;

#define LAS __attribute__((address_space(3)))
typedef unsigned short bf16_t;
typedef short bf16x8 __attribute__((ext_vector_type(8)));
typedef float f32x4 __attribute__((ext_vector_type(4)));
typedef unsigned u32x4 __attribute__((ext_vector_type(4)));
typedef unsigned u32x2 __attribute__((ext_vector_type(2)));

constexpr int SEQ = 4096, MT = 16384, DM = 2048, DBR = 1024, NIN = 19200  , LDH = 11008  , INW = 18992;
constexpr int C_U = 0, C_V = 1024, C_GA = 2048, C_XB = 3072, C_GB = 4096, C_Q = 5120, C_KC = 6144, C_VC = 6400, C_KS = 6656, C_VS = 6912,
              C_KW = 7168, C_VW = 7424, C_GC = 7680, C_QM = 8704, C_GM = 9728, C_GL = 10752  , N_GMG = 10752, N_GL = 18944  ;
constexpr float LOG2E = 1.4426950408889634f;
constexpr float NEGBIG = -1e30f;

constexpr size_t WS_XB   = 4096;
constexpr size_t WS_WIN  = WS_XB   + (size_t)MT * DM * 2;
constexpr size_t WS_WBR  = WS_WIN  + (size_t)NIN * DM * 2;
constexpr size_t WS_WOUT = WS_WBR  + (size_t)4 * DM * DBR * 2;
constexpr size_t WS_WMEM = WS_WOUT + (size_t)DM * DM * 2;
constexpr size_t WS_MEMB = WS_WMEM + (size_t)DM * DM * 2;
constexpr size_t WS_W1T  = WS_MEMB + (size_t)1024 * DM * 2;
constexpr size_t WS_WAT  = WS_W1T  + (size_t)2 * 256 * 2048 * 2;
constexpr size_t WS_SGW  = WS_WAT  + (size_t)2 * 8 * 128 * 128 * 2;
constexpr size_t WS_LUT  = WS_SGW  + (size_t)8 * 128 * 128 * 2;
constexpr size_t WS_PEW1 = WS_LUT  + (size_t)16 * 4096 * 4;
constexpr size_t WS_H    = WS_PEW1 + 8192;
constexpr size_t WS_MKV  = WS_H    + (size_t)MT * LDH * 2;
constexpr size_t WS_LRA  = WS_MKV  + (size_t)1024 * DM * 2;
constexpr size_t WS_LRG  = WS_LRA  + (size_t)MT * DBR * 4;
constexpr size_t WS_O    = WS_LRG  + (size_t)MT * DBR * 4;
constexpr size_t WS_A0   = WS_O    + (size_t)4 * MT * DBR * 2;
constexpr size_t WS_HID  = WS_A0   + (size_t)2 * 4096 * 2048 * 2;
constexpr size_t WS_KCV  = WS_HID  + (size_t)2 * 4096 * 256 * 2;
constexpr size_t WS_AGG  = WS_KCV  + (size_t)2 * 4096 * 64 * 2;
constexpr size_t WS_PARK = WS_AGG  + (size_t)2 * 128 * 1024 * 4;
constexpr size_t WS_G8   = WS_PARK + (size_t)256 * 8 * 8 * 64 * 16;
constexpr size_t WS_XB2  = WS_G8   + (size_t)MT * 8192;
constexpr size_t WS_LNX  = WS_XB2  + (size_t)MT * DM * 2;
constexpr size_t WS_END  = WS_LNX  + (size_t)64 * 256 * 8 * 8;

constexpr int LDS_BYTES = 147456, PL_OFF = 147200;

struct Params {
    const float* in[27];
    float* out;
    unsigned char* ws;
    int ph_lo, ph_hi;
};
typedef unsigned long long u64_t;
struct InAcc { const LAS u64_t* pl;
    __device__ __forceinline__ const float* operator[](int k) const { const u64_t v = pl[k];
        const unsigned lo = __builtin_amdgcn_readfirstlane((unsigned)v), hi = __builtin_amdgcn_readfirstlane((unsigned)(v >> 32)); return (const float*)(const __attribute__((address_space(1))) float*)(((u64_t)hi << 32) | lo); } };
struct Ctx { InAcc in; float* out; unsigned char* ws; };

__device__ __forceinline__ unsigned cvt_pk_bf16(float lo, float hi) { unsigned r; asm("v_cvt_pk_bf16_f32 %0, %1, %2" : "=v"(r) : "v"(lo), "v"(hi)); return r; }
__device__ __forceinline__ float bflo(unsigned w) { return __uint_as_float(w << 16); }
__device__ __forceinline__ float bfhi(unsigned w) { return __uint_as_float(w & 0xffff0000u); }
__device__ __forceinline__ float bf2f(bf16_t v) { return __uint_as_float(((unsigned)v) << 16); }
__device__ __forceinline__ float sigmoidf_(float x) { return __builtin_amdgcn_rcpf(1.0f + __expf(-x)); }
__device__ __forceinline__ float siluf_(float x) { return x * __builtin_amdgcn_rcpf(1.0f + __expf(-x)); }
__device__ __forceinline__ float gelu_tanh(float x) { const float u = 0.7978845608028654f * (x + 0.044715f * x * x * x); return x * __builtin_amdgcn_rcpf(1.0f + __expf(-2.0f * u)); }
__device__ __forceinline__ float rows_max(float x) {
    auto a = __builtin_amdgcn_permlane16_swap(__float_as_uint(x), __float_as_uint(x), false, false); x = fmaxf(__uint_as_float(a[0]), __uint_as_float(a[1]));
    auto b = __builtin_amdgcn_permlane32_swap(__float_as_uint(x), __float_as_uint(x), false, false); return fmaxf(__uint_as_float(b[0]), __uint_as_float(b[1])); }
__device__ __forceinline__ float rows_sum(float x) {
    auto a = __builtin_amdgcn_permlane16_swap(__float_as_uint(x), __float_as_uint(x), false, false); x = __uint_as_float(a[0]) + __uint_as_float(a[1]);
    auto b = __builtin_amdgcn_permlane32_swap(__float_as_uint(x), __float_as_uint(x), false, false); return __uint_as_float(b[0]) + __uint_as_float(b[1]); }
__device__ __forceinline__ int opaque_tid() { int t = threadIdx.x; asm volatile("" : "+v"(t)); return t; }
__device__ __forceinline__ float wave_sum(float v) {
#pragma unroll
    for (int o = 8; o >= 1; o >>= 1) v += __shfl_xor(v, o);
    return rows_sum(v); }
__device__ __forceinline__ float wave_max(float v) {
#pragma unroll
    for (int o = 8; o >= 1; o >>= 1) v = fmaxf(v, __shfl_xor(v, o));
    return rows_max(v); }
__device__ __forceinline__ f32x4 mfma16(bf16x8 a, bf16x8 b, f32x4 c) { return __builtin_amdgcn_mfma_f32_16x16x32_bf16(a, b, c, 0, 0, 0); }
__device__ __forceinline__ int rel_bucket(int n) {
    if (n < 16) return n < 0 ? 0 : n;
    return 16 + (n >= 21) + (n >= 27) + (n >= 35) + (n >= 46) + (n >= 59) + (n >= 77) + (n >= 99) + (n >= 128) + (n >= 166) + (n >= 216) + (n >= 280) + (n >= 363) + (n >= 470) + (n >= 609) + (n >= 790);
}

namespace pg8 {
constexpr int BM = 256, BK = 64, HALF = 128, HTB = HALF * BK * 2, STAGE_BYTES = 8 * HTB, NXCD = 8, WGM = 8;
__device__ __forceinline__ int lds_byte(int r, int c) { const int st = (r >> 4) * 2 + (c >> 5), rr = r & 15, cc = c & 31, ob = rr * 64 + cc * 2; return st * 1024 + (ob ^ (((ob >> 9) & 1) << 5)); }
__device__ __forceinline__ void stage_rc(int b, int& R, int& C) { const int st = b / 1024, sb = b % 1024, swz = sb ^ (((sb >> 9) & 1) << 5); R = (st >> 1) * 16 + swz / 64; C = (st & 1) * 32 + (swz % 64) / 2; }
__device__ __forceinline__ int perm32(int rho) { const int n = rho >> 4, i = rho & 15; return 8 * (i >> 2) + 4 * n + (i & 3); }
struct Unit { int pm, pn, z; };

__device__ __forceinline__ bool static_next(long L, int nM, int nN, Unit& u) {
    const int nwg = nM * nN; if (L >= nwg) return false;
    int wgid = (int)L; { const int q = nwg / NXCD, r = nwg % NXCD, xcd = wgid % NXCD, off = wgid / NXCD; wgid = (xcd < r ? xcd * (q + 1) : r * (q + 1) + (xcd - r) * q) + off; }
    const int nig = WGM * nN, gid = wgid / nig, fm = gid * WGM, gsz = (nM - fm) < WGM ? (nM - fm) : WGM;
    u.pm = fm + ((wgid % nig) % gsz); u.pn = (wgid % nig) / gsz; u.z = 0; return true;
}
struct SchedStd {
    int nM, nN, G, c, K; const bf16_t* A; const bf16_t* B;
    __device__ __forceinline__ bool next(int i, Unit& u) const { return static_next((long)i * G + c, nM, nN, u); }
    __device__ __forceinline__ const char* aptr(const Unit& u) const { return (const char*)(A + (size_t)u.pm * 256 * K); }
    __device__ __forceinline__ const char* bptr(const Unit& u) const { return (const char*)(B + (size_t)u.pn * 256 * K); }
};
struct SchedCmp1 {
    int c; const bf16_t* A0; const bf16_t* W1T;
    __device__ __forceinline__ bool next(int i, Unit& u) const { if (i > 0 || c >= 32) return false; u.z = c >> 4; u.pm = c & 15; u.pn = 0; return true; }
    __device__ __forceinline__ const char* aptr(const Unit& u) const { return (const char*)(A0 + ((size_t)u.z * 4096 + (size_t)u.pm * 256) * 2048); }
    __device__ __forceinline__ const char* bptr(const Unit& u) const { return (const char*)(W1T + (size_t)u.z * 256 * 2048); }
};
struct SchedMerge {
    int G, c; const bf16_t* O; const bf16_t* WBR;
    __device__ __forceinline__ bool next(int i, Unit& u) const { const bool ok = static_next((long)(i >> 2) * G + c, 64, 8, u); u.z = i & 3; return ok; }
    __device__ __forceinline__ const char* aptr(const Unit& u) const { return (const char*)(O + ((size_t)u.z * MT + (size_t)u.pm * 256) * DBR); }
    __device__ __forceinline__ const char* bptr(const Unit& u) const { return (const char*)(WBR + ((size_t)u.z * DM + (size_t)u.pn * 256) * DBR); }
};

struct SchedOut {
    int c; const bf16_t* A; const bf16_t* B;
    __device__ __forceinline__ bool next(int i, Unit& u) const { if (i > 1) return false; const int x = c & 7, k = c >> 3; u.pm = 32 * i + 4 * x + (k >> 3); u.pn = k & 7; u.z = 0; return true; }
    __device__ __forceinline__ const char* aptr(const Unit& u) const { return (const char*)(A + (size_t)u.pm * 256 * DM); }
    __device__ __forceinline__ const char* bptr(const Unit& u) const { return (const char*)(B + (size_t)u.pn * 256 * DM); }
};
template <class Epi, class Sched>
__device__ __forceinline__ void gemm_phase(LAS unsigned char* lds, const int K, const Sched& S, const Epi& E) {
    const int tid = opaque_tid(), wid = __builtin_amdgcn_readfirstlane(tid >> 6), lane = tid & 63, wr = wid >> 2, wc = wid & 3, fr = lane & 15, fq = lane >> 4;
    const int nt = K / BK;
    unsigned voffA[2], voffB[2];
#pragma unroll
    for (int i = 0; i < 2; ++i) { int R, C; stage_rc(tid * 16 + i * 8192, R, C); const int Rb = Epi::PERM ? ((R & ~31) + perm32(R & 31)) : R;
        voffA[i] = (unsigned)(R * K + C) * 2u; voffB[i] = (unsigned)(Rb * K + C) * 2u; }
    const size_t kstep = (size_t)(BK * 2);
    const size_t hstep = (size_t)HALF * K * 2;
    const unsigned ldsw = (unsigned)wid * 1024u;
    const int aoff = lds_byte(wr * 64 + fr, fq * 8), boff = lds_byte(wc * 32 + fr, fq * 8);
#define PG8_SA(b, h) (((b) * 2 + (h)) * HTB)
#define PG8_SB(b, h) ((4 + (b) * 2 + (h)) * HTB)
#define PG8_STAGE(bufoff, gbase, voff) do { _Pragma("unroll") for (int _i = 0; _i < 2; ++_i) \
        __builtin_amdgcn_global_load_lds((const unsigned*)((const char*)(gbase) + (voff)[_i]), (LAS unsigned*)(lds + (bufoff) + ldsw + _i * 8192), 16, 0, 0); } while (0)
#define PG8_LDA(dst, b, h) do { _Pragma("unroll") for (int m = 0; m < 4; ++m) _Pragma("unroll") for (int k = 0; k < 2; ++k) dst[m][k] = *(const LAS bf16x8*)(lds + PG8_SA(b, h) + aoff + m * 2048 + k * 1024); } while (0)
#define PG8_LDB(dst, b, h) do { _Pragma("unroll") for (int n = 0; n < 2; ++n) _Pragma("unroll") for (int k = 0; k < 2; ++k) dst[n][k] = *(const LAS bf16x8*)(lds + PG8_SB(b, h) + boff + n * 2048 + k * 1024); } while (0)
#define PG8_MMA(ai, bj, At, Bt) do { __builtin_amdgcn_s_setprio(1); _Pragma("unroll") for (int m = 0; m < 4; ++m) _Pragma("unroll") for (int n = 0; n < 2; ++n) _Pragma("unroll") for (int k = 0; k < 2; ++k) \
        acc[ai][bj][m][n] = __builtin_amdgcn_mfma_f32_16x16x32_bf16(Bt[n][k], At[m][k], acc[ai][bj][m][n], 0, 0, 0); __builtin_amdgcn_s_setprio(0); } while (0)
#define PG8_WAIT_V(n) asm volatile("s_waitcnt vmcnt(" #n ")" ::: "memory")
#define PG8_WAIT_L(n) asm volatile("s_waitcnt lgkmcnt(" #n ")" ::: "memory")
#define PG8_BAR __builtin_amdgcn_s_barrier()
#define PG8_SCHED __builtin_amdgcn_sched_barrier(0)
    Unit cur, nxt; int ui = 0;
    if (!S.next(0, cur)) return;
    f32x4 acc[2][2][4][2];
#pragma unroll
    for (int a = 0; a < 2; ++a)
#pragma unroll
        for (int b = 0; b < 2; ++b)
#pragma unroll
            for (int m = 0; m < 4; ++m)
#pragma unroll
                for (int n = 0; n < 2; ++n) acc[a][b][m][n] = (f32x4){0.f, 0.f, 0.f, 0.f};
    bf16x8 At[4][2], B0[2][2], B1[2][2];
    const char* cA = S.aptr(cur); const char* cB = S.bptr(cur);
    PG8_STAGE(PG8_SB(0, 0), cB, voffB); PG8_STAGE(PG8_SB(0, 1), cB + hstep, voffB); PG8_STAGE(PG8_SA(0, 0), cA, voffA); PG8_STAGE(PG8_SA(0, 1), cA + hstep, voffA);
    if (wr == 1) PG8_BAR;
    PG8_WAIT_V(2); PG8_BAR;
    PG8_STAGE(PG8_SB(1, 0), cB + kstep, voffB); PG8_STAGE(PG8_SA(1, 0), cA + kstep, voffA); PG8_STAGE(PG8_SB(1, 1), cB + hstep + kstep, voffB);
    PG8_WAIT_V(6); PG8_BAR;
    for (;;) {
        const bool has_next = S.next(ui + 1, nxt);
        const char* nA = has_next ? S.aptr(nxt) : cA; const char* nB = has_next ? S.bptr(nxt) : cB;
        for (int t = 0; t < nt; t += 2) {
            const bool last = (t == nt - 2);
            const char* a1 = cA + (size_t)(t + 1) * kstep;
            const char* a2 = last ? nA : cA + (size_t)(t + 2) * kstep; const char* b2 = last ? nB : cB + (size_t)(t + 2) * kstep;
            const char* a3 = a2 + kstep; const char* b3 = b2 + kstep;
            PG8_LDB(B0, 0, 0); PG8_LDB(B1, 0, 1); PG8_SCHED; PG8_LDA(At, 0, 0); PG8_STAGE(PG8_SA(1, 1), a1 + hstep, voffA);
            PG8_WAIT_V(8); PG8_WAIT_L(0); PG8_BAR; PG8_MMA(0, 0, At, B0); PG8_MMA(0, 1, At, B1); PG8_BAR; PG8_SCHED;
            PG8_LDA(At, 0, 1); PG8_STAGE(PG8_SB(0, 0), b2, voffB); PG8_STAGE(PG8_SB(0, 1), b2 + hstep, voffB); PG8_STAGE(PG8_SA(0, 0), a2, voffA);
            PG8_WAIT_V(8); PG8_WAIT_L(0); PG8_BAR; PG8_MMA(1, 0, At, B0); PG8_MMA(1, 1, At, B1); PG8_BAR; PG8_SCHED;
            PG8_LDB(B0, 1, 0); PG8_LDB(B1, 1, 1); PG8_SCHED; PG8_LDA(At, 1, 0); PG8_STAGE(PG8_SA(0, 1), a2 + hstep, voffA);
            PG8_WAIT_V(8); PG8_WAIT_L(0); PG8_BAR; PG8_MMA(0, 0, At, B0); PG8_MMA(0, 1, At, B1); PG8_BAR; PG8_SCHED;
            PG8_LDA(At, 1, 1); PG8_STAGE(PG8_SB(1, 0), b3, voffB); PG8_STAGE(PG8_SB(1, 1), b3 + hstep, voffB); PG8_STAGE(PG8_SA(1, 0), a3, voffA);
            PG8_WAIT_V(8); PG8_WAIT_L(0); PG8_BAR; PG8_MMA(1, 0, At, B0); PG8_MMA(1, 1, At, B1); PG8_BAR; PG8_SCHED;
        }
        if (wr == 0) PG8_BAR;
        E(acc, cur, wr, wc, fr, fq);
        if (!has_next) break;
#pragma unroll
        for (int a = 0; a < 2; ++a)
#pragma unroll
            for (int b = 0; b < 2; ++b)
#pragma unroll
                for (int m = 0; m < 4; ++m)
#pragma unroll
                    for (int n = 0; n < 2; ++n) acc[a][b][m][n] = (f32x4){0.f, 0.f, 0.f, 0.f};
        cur = nxt; cA = nA; cB = nB; ++ui;
        if (wr == 1) PG8_BAR;
    }
    PG8_WAIT_V(0);
    PG8_BAR;
#undef PG8_SA
#undef PG8_SB
#undef PG8_STAGE
#undef PG8_LDA
#undef PG8_LDB
#undef PG8_MMA
#undef PG8_WAIT_V
#undef PG8_WAIT_L
#undef PG8_BAR
#undef PG8_SCHED
}

__device__ __forceinline__ int act_of(int col) {
    if (col < 2048) return 1; if (col < 3072) return 2; if (col < 4096) return 0; if (col < 5120) return 2; if (col < 7680) return 0;
    if (col < 8704) return 2; if (col < 9728) return 0; if (col < 10752) return 2; if (col < 18944) return 3; return 0;
}
struct EpiInProj {
    static constexpr bool PERM = true;
    bf16_t* H; unsigned char* G8;
    __device__ __forceinline__ void operator()(const f32x4 (&acc)[2][2][4][2], const Unit& u, int wr, int wc, int fr, int fq) const {
        const int row0 = u.pm * BM + wr * 64 + fr, colt = u.pn * BM;
        const int act = act_of(colt);
        if (act == 3) {
            unsigned char* gp = G8 + (colt - N_GMG) + wc * 32 + 8 * fq;
#pragma unroll
            for (int ai = 0; ai < 2; ++ai)
#pragma unroll
                for (int m = 0; m < 4; ++m) { unsigned char* rowp = gp + (size_t)(row0 + ai * HALF + m * 16) * 8192;
#pragma unroll
                    for (int bj = 0; bj < 2; ++bj) { unsigned q[8];
#pragma unroll
                        for (int n = 0; n < 2; ++n)
#pragma unroll
                            for (int j = 0; j < 4; j += 2) { typedef float f32x2 __attribute__((ext_vector_type(2)));
                                const f32x2 x = {acc[ai][bj][m][n][j], acc[ai][bj][m][n][j + 1]}; const f32x2 t = x * (-LOG2E);
                                f32x2 d = {__builtin_amdgcn_exp2f(t.x), __builtin_amdgcn_exp2f(t.y)}; d = d + 1.0f;
                                f32x2 r = {__builtin_amdgcn_rcpf(d.x), __builtin_amdgcn_rcpf(d.y)}; r = r * 255.0f + 0.5f;
                                q[4 * n + j] = (unsigned)r.x; q[4 * n + j + 1] = (unsigned)r.y; }
                        u32x2 w; w.x = q[0] | (q[1] << 8) | (q[2] << 16) | (q[3] << 24); w.y = q[4] | (q[5] << 8) | (q[6] << 16) | (q[7] << 24);
                        *(u32x2*)(rowp + bj * HALF) = w; } }
            return;
        }
        const int col0 = (colt >= N_GL ? C_GL : colt) + wc * 32 + 8 * fq;
        const float k1 = (act == 1) ? -1.5957691216057308f * LOG2E : -LOG2E, k3 = (act == 1) ? -1.5957691216057308f * 0.044715f * LOG2E : 0.f;
#pragma unroll
        for (int ai = 0; ai < 2; ++ai)
#pragma unroll
            for (int m = 0; m < 4; ++m) { bf16_t* rowp = H + (size_t)(row0 + ai * HALF + m * 16) * LDH + col0;
#pragma unroll
                for (int bj = 0; bj < 2; ++bj) { float v[8];
#pragma unroll
                    for (int j = 0; j < 4; ++j) { v[j] = acc[ai][bj][m][0][j]; v[4 + j] = acc[ai][bj][m][1][j]; }
                    if (act != 0) {
#pragma unroll
                        for (int j = 0; j < 8; j += 2) { typedef float f32x2 __attribute__((ext_vector_type(2)));
                            const f32x2 x = {v[j], v[j + 1]}; const f32x2 t = x * (x * x * k3 + k1);
                            f32x2 d = {__builtin_amdgcn_exp2f(t.x), __builtin_amdgcn_exp2f(t.y)}; d = d + 1.0f;
                            const f32x2 r = {__builtin_amdgcn_rcpf(d.x), __builtin_amdgcn_rcpf(d.y)}; const f32x2 y = x * r; v[j] = y.x; v[j + 1] = y.y; }
                    }
                    u32x4 w; w.x = cvt_pk_bf16(v[0], v[1]); w.y = cvt_pk_bf16(v[2], v[3]); w.z = cvt_pk_bf16(v[4], v[5]); w.w = cvt_pk_bf16(v[6], v[7]);
                    *(u32x4*)(rowp + bj * HALF) = w; } }
    }
};
struct EpiBf16 {
    static constexpr bool PERM = true;
    bf16_t* O; int ldc; size_t zstride; const float* bias; int zbias; int act;
    __device__ __forceinline__ void operator()(const f32x4 (&acc)[2][2][4][2], const Unit& u, int wr, int wc, int fr, int fq) const {
        const int row0 = u.pm * BM + wr * 64 + fr, col0 = u.pn * BM + wc * 32 + 8 * fq;
        bf16_t* base = O + (size_t)u.z * zstride;
#pragma unroll
        for (int ai = 0; ai < 2; ++ai)
#pragma unroll
            for (int m = 0; m < 4; ++m) { bf16_t* rowp = base + (size_t)(row0 + ai * HALF + m * 16) * ldc + col0;
#pragma unroll
                for (int bj = 0; bj < 2; ++bj) { float v[8];
#pragma unroll
                    for (int j = 0; j < 4; ++j) { v[j] = acc[ai][bj][m][0][j]; v[4 + j] = acc[ai][bj][m][1][j]; }
                    if (bias) {
#pragma unroll
                        for (int j = 0; j < 8; ++j) v[j] += bias[u.z * zbias + col0 + bj * HALF + j];
                    }
                    if (act == 2) {
#pragma unroll
                        for (int j = 0; j < 8; ++j) v[j] = siluf_(v[j]);
                    }
                    u32x4 w; w.x = cvt_pk_bf16(v[0], v[1]); w.y = cvt_pk_bf16(v[2], v[3]); w.z = cvt_pk_bf16(v[4], v[5]); w.w = cvt_pk_bf16(v[6], v[7]);
                    *(u32x4*)(rowp + bj * HALF) = w; } }
    }
};
struct EpiMerge {
    static constexpr bool PERM = true;
    bf16_t* Mg; const unsigned char* G8;
    __device__ __forceinline__ void operator()(const f32x4 (&acc)[2][2][4][2], const Unit& u, int wr, int wc, int fr, int fq) const {
        const int row0 = u.pm * BM + wr * 64 + fr, col0 = u.pn * BM + wc * 32 + 8 * fq;
        u32x2 g[2][4][2];
#pragma unroll
        for (int ai = 0; ai < 2; ++ai)
#pragma unroll
            for (int m = 0; m < 4; ++m) { const unsigned char* gp = G8 + (size_t)(row0 + ai * HALF + m * 16) * 8192 + u.z * DM + col0;
#pragma unroll
                for (int bj = 0; bj < 2; ++bj) g[ai][m][bj] = *(const u32x2*)(gp + bj * HALF); }
#pragma unroll
        for (int ai = 0; ai < 2; ++ai) {
            u32x4 p[4][2];
#pragma unroll
            for (int m = 0; m < 4; ++m)
#pragma unroll
                for (int bj = 0; bj < 2; ++bj) { p[m][bj] = (u32x4){0u, 0u, 0u, 0u}; if (u.z > 0) p[m][bj] = *(const u32x4*)(Mg + (size_t)(row0 + ai * HALF + m * 16) * DM + col0 + bj * HALF); }
#pragma unroll
            for (int m = 0; m < 4; ++m) { bf16_t* mp = Mg + (size_t)(row0 + ai * HALF + m * 16) * DM + col0;
#pragma unroll
                for (int bj = 0; bj < 2; ++bj) { const u32x2 gg = g[ai][m][bj]; const u32x4 pp = p[m][bj];
                    const f32x4 a0 = acc[ai][bj][m][0] * (1.0f / 255.0f), a1 = acc[ai][bj][m][1] * (1.0f / 255.0f);
                    const float v0 = (float)(gg.x & 255u) * a0[0] + bflo(pp.x), v1 = (float)((gg.x >> 8) & 255u) * a0[1] + bfhi(pp.x), v2 = (float)((gg.x >> 16) & 255u) * a0[2] + bflo(pp.y), v3 = (float)(gg.x >> 24) * a0[3] + bfhi(pp.y);
                    const float v4 = (float)(gg.y & 255u) * a1[0] + bflo(pp.z), v5 = (float)((gg.y >> 8) & 255u) * a1[1] + bfhi(pp.z), v6 = (float)((gg.y >> 16) & 255u) * a1[2] + bflo(pp.w), v7 = (float)(gg.y >> 24) * a1[3] + bfhi(pp.w);
                    u32x4 w; w.x = cvt_pk_bf16(v0, v1); w.y = cvt_pk_bf16(v2, v3); w.z = cvt_pk_bf16(v4, v5); w.w = cvt_pk_bf16(v6, v7);
                    *(u32x4*)(mp + bj * HALF) = w; } } }
    }
};
struct EpiOutLN {
    static constexpr bool PERM = false;
    const float* xres; float* out; bf16_t* xb; const float* lg; const float* lb; unsigned* cnt; unsigned long long* slots; LAS unsigned char* lx;
    __device__ __forceinline__ void operator()(f32x4 (&acc)[2][2][4][2], const Unit& u, int wr, int wc, int fr, int fq) const {
        typedef float f32x2v __attribute__((ext_vector_type(2)));
        LAS f32x2v* Pt = (LAS f32x2v*)lx;
        LAS f32x2v* St = (LAS f32x2v*)(lx + 8192);
        const int tid = opaque_tid(), wid = tid >> 6, lane = tid & 63;
        const int row0 = u.pm * BM + wr * 64 + fr, col0 = u.pn * BM + wc * 32 + 4 * fq;
#pragma unroll
        for (int ai = 0; ai < 2; ++ai)
#pragma unroll
            for (int m = 0; m < 4; ++m) { const size_t off = (size_t)(row0 + ai * HALF + m * 16) * DM + col0; float sm = 0.f;
#pragma unroll
                for (int bj = 0; bj < 2; ++bj)
#pragma unroll
                    for (int n = 0; n < 2; ++n) { const f32x4 x = *(const f32x4*)(xres + off + bj * HALF + n * 16); const f32x4 z = x * 1.4142135623730951f + acc[ai][bj][m][n];
                        acc[ai][bj][m][n] = z; sm += (z[0] + z[1]) + (z[2] + z[3]); }
                sm += __shfl_xor(sm, 16); sm += __shfl_xor(sm, 32);
                const float mw = sm * (1.0f / 64.0f); float q = 0.f;
#pragma unroll
                for (int bj = 0; bj < 2; ++bj)
#pragma unroll
                    for (int n = 0; n < 2; ++n) { const f32x4 d = acc[ai][bj][m][n] - mw; q += (d[0] * d[0] + d[1] * d[1]) + (d[2] * d[2] + d[3] * d[3]); }
                q += __shfl_xor(q, 16); q += __shfl_xor(q, 32);
                if (fq == 0) Pt[(ai * HALF + wr * 64 + m * 16 + fr) * 4 + wc] = (f32x2v){mw, q}; }
        __syncthreads();
        const int row = wid * 32 + (lane & 31);
        if (lane < 32) { const f32x2v a = Pt[row * 4 + 0], b = Pt[row * 4 + 1], c = Pt[row * 4 + 2], d = Pt[row * 4 + 3];
            const float mt = (a.x + b.x + c.x + d.x) * 0.25f; const float da = a.x - mt, db = b.x - mt, dc = c.x - mt, dd = d.x - mt;
            const float m2 = (a.y + b.y) + (c.y + d.y) + 64.0f * ((da * da + db * db) + (dc * dc + dd * dd));
            __hip_atomic_store(slots + ((size_t)(u.pm * BM + row) * 8 + u.pn), ((unsigned long long)__float_as_uint(m2) << 32) | __float_as_uint(mt), __ATOMIC_RELAXED, __HIP_MEMORY_SCOPE_AGENT); }
        asm volatile("s_waitcnt vmcnt(0)" ::: "memory");
        if (lane == 0) __hip_atomic_fetch_add(cnt + u.pm, 1u, __ATOMIC_RELAXED, __HIP_MEMORY_SCOPE_AGENT);
        if (wid == 0) { unsigned polls = 0;
            while ((unsigned)__builtin_amdgcn_readfirstlane(__hip_atomic_load(cnt + u.pm, __ATOMIC_RELAXED, __HIP_MEMORY_SCOPE_AGENT)) < 64u) { if (++polls > (1u << 22)) break; __builtin_amdgcn_s_sleep(2); }
            __builtin_amdgcn_fence(__ATOMIC_ACQUIRE, "agent"); }
        asm volatile("s_waitcnt vmcnt(0) lgkmcnt(0)" ::: "memory");
        __syncthreads();
        if (lane < 32) { const unsigned long long* sl = slots + (size_t)(u.pm * BM + row) * 8; float mt[8], m2[8]; float ms = 0.f;
#pragma unroll
            for (int t = 0; t < 8; ++t) { const unsigned long long w = __hip_atomic_load(sl + t, __ATOMIC_RELAXED, __HIP_MEMORY_SCOPE_AGENT); mt[t] = __uint_as_float((unsigned)w); m2[t] = __uint_as_float((unsigned)(w >> 32)); ms += mt[t]; }
            const float mean = ms * 0.125f; float q = 0.f;
#pragma unroll
            for (int t = 0; t < 8; ++t) { const float dm = mt[t] - mean; q += m2[t] + 256.0f * dm * dm; }
            St[row] = (f32x2v){mean, rsqrtf(q * (1.0f / 2048.0f) + 1e-5f)}; }
        __syncthreads();
#pragma unroll
        for (int ai = 0; ai < 2; ++ai)
#pragma unroll
            for (int m = 0; m < 4; ++m) { const int rl = ai * HALF + wr * 64 + m * 16 + fr; const f32x2v sr = St[rl]; const size_t off = (size_t)(u.pm * BM + rl) * DM + col0;
#pragma unroll
                for (int bj = 0; bj < 2; ++bj)
#pragma unroll
                    for (int n = 0; n < 2; ++n) { const int co = bj * HALF + n * 16; const f32x4 gg = *(const f32x4*)(lg + col0 + co), bb = *(const f32x4*)(lb + col0 + co);
                        const f32x4 y = (acc[ai][bj][m][n] - sr.x) * sr.y * gg + bb; *(f32x4*)(out + off + co) = y;
                        if (xb) { u32x2 w; w.x = cvt_pk_bf16(y[0], y[1]); w.y = cvt_pk_bf16(y[2], y[3]); *(u32x2*)(xb + off + co) = w; } } }
        __syncthreads();
    }
};
}

__device__ __forceinline__ void tconv_tile(LAS float* tile, const float* src, int ld, int k0, int n0, int mode, bf16_t* dst, int K) {
    const int tid = opaque_tid();
#pragma unroll
    for (int it = 0; it < 2; ++it) { const int idx = tid + it * 512, kk = idx >> 4, n4 = (idx & 15) * 4, nn = n0 + n4; int oc = nn; bool valid = true;
        if (mode == 1) { if (nn < 7680) oc = nn; else if (nn < 18944) oc = nn + 48; else if (nn < INW) oc = 7680 + (nn - 18944); else valid = false; }
        f32x4 v = (f32x4){0.f, 0.f, 0.f, 0.f}; if (valid) v = *(const f32x4*)(src + (size_t)(k0 + kk) * ld + oc);
        tile[kk * 65 + n4 + 0] = v[0]; tile[kk * 65 + n4 + 1] = v[1]; tile[kk * 65 + n4 + 2] = v[2]; tile[kk * 65 + n4 + 3] = v[3]; }
    __syncthreads();
    { const int n = tid >> 3, k8 = (tid & 7) * 8; float v[8];
#pragma unroll
        for (int e = 0; e < 8; ++e) v[e] = tile[(k8 + e) * 65 + n];
        u32x4 w; w.x = cvt_pk_bf16(v[0], v[1]); w.y = cvt_pk_bf16(v[2], v[3]); w.z = cvt_pk_bf16(v[4], v[5]); w.w = cvt_pk_bf16(v[6], v[7]);
        *(u32x4*)(dst + (size_t)(n0 + n) * K + k0 + k8) = w; }
    __syncthreads();
}

__device__ __forceinline__ void prologue(LAS unsigned char* lds, const Ctx& P, int l) {
    unsigned char* ws = P.ws; LAS float* tile = (LAS float*)lds;
    const int tid = opaque_tid(), G = gridDim.x;
    const int T_IN = 32 * 300, T_BR = 4 * 512, T_OUT = 1024, T_MEM = 1024, T_W1 = 256, T_WA = 64;
    const int T_ALL = T_IN + T_BR + T_OUT + T_MEM + T_W1 + T_WA;
    for (int t = blockIdx.x; t < T_ALL; t += G) {
        int q = t;
        if (q < T_IN) { const int kt = q & 31, ntl = q >> 5; tconv_tile(tile, P.in[3] + (size_t)l * DM * INW, INW, kt * 64, ntl * 64, 1, (bf16_t*)(ws + WS_WIN), DM); continue; }
        q -= T_IN;
        if (q < T_BR) { const int br = q >> 9, r = q & 511, kt = r & 15, ntl = r >> 4;
            tconv_tile(tile, P.in[23] + ((size_t)l * 4 + br) * DBR * DM, DM, kt * 64, ntl * 64, 0, (bf16_t*)(ws + WS_WBR) + (size_t)br * DM * DBR, DBR); continue; }
        q -= T_BR;
        if (q < T_OUT) { const int kt = q & 31, ntl = q >> 5; tconv_tile(tile, P.in[24] + (size_t)l * DM * DM, DM, kt * 64, ntl * 64, 0, (bf16_t*)(ws + WS_WOUT), DM); continue; }
        q -= T_OUT;
        if (q < T_MEM) { const int kt = q & 31, ntl = q >> 5; tconv_tile(tile, P.in[22] + (size_t)l * DM * DM, DM, kt * 64, ntl * 64, 0, (bf16_t*)(ws + WS_WMEM), DM); continue; }
        q -= T_MEM;
        if (q < T_W1) { const int kv = q >> 7, r = q & 127, kt = r & 31, ntl = r >> 5;
            tconv_tile(tile, P.in[17 + kv] + (size_t)l * 2048 * 256, 256, kt * 64, ntl * 64, 0, (bf16_t*)(ws + WS_W1T) + (size_t)kv * 256 * 2048, 2048); continue; }
        q -= T_W1;
        { const int mat = q >> 5, r = q & 31, n = r >> 2, kt = r & 1, ntl = (r >> 1) & 1;
            tconv_tile(tile, P.in[mat ? 12 : 10] + ((size_t)l * 8 + n) * 128 * 128, 128, kt * 64, ntl * 64, 0, (bf16_t*)(ws + WS_WAT) + ((size_t)mat * 8 + n) * 128 * 128, 128); }
    }
    const size_t gtid = (size_t)blockIdx.x * 512 + tid, gstride = (size_t)G * 512;
    { const float* sw = P.in[6] + (size_t)l * 8 * 128 * 128; bf16_t* d = (bf16_t*)(ws + WS_SGW);
        for (size_t i = gtid; i < (size_t)8 * 128 * 128 / 2; i += gstride) { const size_t e = i * 2; const int s = (int)(e & 127), t = (int)((e >> 7) & 127);
            const float a = (s <= t) ? sw[e] : 0.f, b = (s + 1 <= t) ? sw[e + 1] : 0.f; ((unsigned*)d)[i] = cvt_pk_bf16(a, b); } }
    for (int u = blockIdx.x; u < 8; u += G) { const int kv = u >> 2, cb = u & 3, col = cb * 64 + (tid & 63), ks = tid >> 6;
        const float* pe = P.in[15 + kv] + (size_t)l * 2048; const float* w1 = P.in[17 + kv] + (size_t)l * 2048 * 256; float s = 0.f;
        for (int k = ks * 256; k < ks * 256 + 256; ++k) s += pe[k] * w1[(size_t)k * 256 + col];
        tile[tid] = s; __syncthreads();
        if (tid < 64) { float a = 0.f;
#pragma unroll
            for (int j = 0; j < 8; ++j) a += tile[j * 64 + tid];
            ((float*)(ws + WS_PEW1))[kv * 256 + col] = a; }
        __syncthreads(); }
    { const float* lam = P.in[14] + (size_t)l * DBR; float* sp8 = (float*)(ws + WS_PEW1) + 512;
        for (size_t i = gtid; i < (size_t)DBR; i += gstride) sp8[i] = 8.0f * log1pf(expf(-lam[i])); }
    if (l == 0) {
        { const f32x4* x = (const f32x4*)P.in[0]; u32x2* d = (u32x2*)(ws + WS_XB);
            for (size_t i = gtid; i < (size_t)MT * DM / 4; i += 4 * gstride) { f32x4 v[4];
#pragma unroll
                for (int k = 0; k < 4; ++k) { const size_t j = i + k * gstride; v[k] = (j < (size_t)MT * DM / 4) ? x[j] : (f32x4){0.f, 0.f, 0.f, 0.f}; }
#pragma unroll
                for (int k = 0; k < 4; ++k) { const size_t j = i + k * gstride; if (j < (size_t)MT * DM / 4) { u32x2 w; w.x = cvt_pk_bf16(v[k][0], v[k][1]); w.y = cvt_pk_bf16(v[k][2], v[k][3]); d[j] = w; } } } }
        { const f32x4* x = (const f32x4*)P.in[1]; u32x2* d = (u32x2*)(ws + WS_MEMB);
            for (size_t i = gtid; i < (size_t)1024 * DM / 4; i += gstride) { const f32x4 v = x[i]; u32x2 w; w.x = cvt_pk_bf16(v[0], v[1]); w.y = cvt_pk_bf16(v[2], v[3]); d[i] = w; } }
        { float* lut = (float*)(ws + WS_LUT); const float* rb = P.in[2];
            for (size_t i = gtid; i < (size_t)16 * 4096; i += gstride) { const int h = (int)(i >> 12), dist = (int)(i & 4095); lut[i] = rb[rel_bucket(dist) * 16 + h] * LOG2E; } }
    }
}

template <int D, class SF>
__device__ __forceinline__ void attn_step(const bf16x8 (&qf)[D / 32], const LAS bf16_t* Ks, const LAS bf16_t* Vt, f32x4 (&o)[D / 16], float& m, float& lsum, float& alpha_out, bf16x8& pf0_out, bf16x8& pf1_out, const int lane, SF sf) {
    constexpr int KSTR = D + 8;
    const int c = lane & 15, i = lane >> 4;
    f32x4 s[4];
#pragma unroll
    for (int t = 0; t < 4; ++t) s[t] = (f32x4){0.f, 0.f, 0.f, 0.f};
#pragma unroll
    for (int ks = 0; ks < D / 32; ++ks) {
#pragma unroll
        for (int t = 0; t < 4; ++t) { const bf16x8 kf = *(const LAS bf16x8*)(Ks + (16 * t + c) * KSTR + ks * 32 + 8 * i); s[t] = mfma16(kf, qf[ks], s[t]); }
    }
    float v[16];
#pragma unroll
    for (int t = 0; t < 4; ++t)
#pragma unroll
        for (int r = 0; r < 4; ++r) v[4 * t + r] = sf(16 * t + 4 * i + r, s[t][r]);
    float mx = fmaxf(fmaxf(fmaxf(v[0], v[1]), fmaxf(v[2], v[3])), fmaxf(fmaxf(v[4], v[5]), fmaxf(v[6], v[7])));
    mx = fmaxf(mx, fmaxf(fmaxf(fmaxf(v[8], v[9]), fmaxf(v[10], v[11])), fmaxf(fmaxf(v[12], v[13]), fmaxf(v[14], v[15]))));
    mx = rows_max(mx);
    const float mnew = fmaxf(m, mx);
    const float mc = fmaxf(mnew, -1e20f);
    const float alpha = __builtin_amdgcn_exp2f(fmaxf(m, -1e20f) - mc);
    float p[16], rs = 0.f;
#pragma unroll
    for (int r = 0; r < 16; ++r) { p[r] = __builtin_amdgcn_exp2f(v[r] - mc); rs += p[r]; }
    rs = rows_sum(rs);
    lsum = lsum * alpha + rs; m = mnew;
    union { u32x4 u; bf16x8 b; } pk0, pk1;
    pk0.u.x = cvt_pk_bf16(p[0], p[1]); pk0.u.y = cvt_pk_bf16(p[2], p[3]); pk0.u.z = cvt_pk_bf16(p[4], p[5]); pk0.u.w = cvt_pk_bf16(p[6], p[7]);
    pk1.u.x = cvt_pk_bf16(p[8], p[9]); pk1.u.y = cvt_pk_bf16(p[10], p[11]); pk1.u.z = cvt_pk_bf16(p[12], p[13]); pk1.u.w = cvt_pk_bf16(p[14], p[15]);
    if (__builtin_amdgcn_ballot_w64(alpha != 1.0f) != 0ull) {
#pragma unroll
        for (int dt = 0; dt < D / 16; ++dt) o[dt] *= alpha;
    }
#pragma unroll
    for (int dt = 0; dt < D / 16; ++dt) {
        const LAS bf16_t* vp = Vt + (16 * dt + c) * 72 + 4 * i;
        union { u32x4 u; bf16x8 b; } vf0, vf1; const u32x2 a0 = *(const LAS u32x2*)vp, a1 = *(const LAS u32x2*)(vp + 16), b0 = *(const LAS u32x2*)(vp + 32), b1 = *(const LAS u32x2*)(vp + 48);
        vf0.u.x = a0.x; vf0.u.y = a0.y; vf0.u.z = a1.x; vf0.u.w = a1.y; vf1.u.x = b0.x; vf1.u.y = b0.y; vf1.u.z = b1.x; vf1.u.w = b1.y;
        o[dt] = mfma16(vf0.b, pk0.b, o[dt]); o[dt] = mfma16(vf1.b, pk1.b, o[dt]);
    }
    alpha_out = alpha; pf0_out = pk0.b; pf1_out = pk1.b;
}
template <int D>
__device__ __forceinline__ void load_k_tile(const int tid, LAS bf16_t* Ks, const bf16_t* src, size_t ld, int p0, int pmax) {
#pragma unroll
    for (int it = 0; it < D / 64; ++it) { const int idx = tid + it * 512, key = idx & 63, seg = idx >> 6, p = p0 + key;
        u32x4 v = (u32x4){0u, 0u, 0u, 0u}; if (p >= 0 && p <= pmax) v = *(const u32x4*)(src + (size_t)p * ld + seg * 8);
        *(LAS u32x4*)(Ks + key * (D + 8) + seg * 8) = v; }
}
template <int D>
__device__ __forceinline__ void load_vt_tile(const int tid, LAS bf16_t* Vt, const bf16_t* src, size_t ld, int p0, int pmax) {
#pragma unroll
    for (int it = 0; it < D / 64; ++it) { const int idx = tid + it * 512, key = idx & 63, seg = idx >> 6, p = p0 + key;
        u32x4 v = (u32x4){0u, 0u, 0u, 0u}; if (p >= 0 && p <= pmax) v = *(const u32x4*)(src + (size_t)p * ld + seg * 8);
        LAS bf16_t* d = Vt + (seg * 8) * 72 + key;
        d[0 * 72] = (bf16_t)(v.x & 0xffffu); d[1 * 72] = (bf16_t)(v.x >> 16); d[2 * 72] = (bf16_t)(v.y & 0xffffu); d[3 * 72] = (bf16_t)(v.y >> 16);
        d[4 * 72] = (bf16_t)(v.z & 0xffffu); d[5 * 72] = (bf16_t)(v.z >> 16); d[6 * 72] = (bf16_t)(v.w & 0xffffu); d[7 * 72] = (bf16_t)(v.w >> 16); }
}
__device__ __forceinline__ bf16x8 load_q_scaled(const bf16_t* p, float scale) {
    const u32x4 r = *(const u32x4*)p; union { u32x4 u; bf16x8 b; } q;
    q.u.x = cvt_pk_bf16(bflo(r.x) * scale, bfhi(r.x) * scale); q.u.y = cvt_pk_bf16(bflo(r.y) * scale, bfhi(r.y) * scale);
    q.u.z = cvt_pk_bf16(bflo(r.z) * scale, bfhi(r.z) * scale); q.u.w = cvt_pk_bf16(bflo(r.w) * scale, bfhi(r.w) * scale); return q.b;
}

__device__ __forceinline__ void memattn_unit(LAS unsigned char* lds, const Ctx& P, int unit) {
    const bf16_t* H = (const bf16_t*)(P.ws + WS_H); const bf16_t* MKV = (const bf16_t*)(P.ws + WS_MKV); bf16_t* O = (bf16_t*)(P.ws + WS_O) + (size_t)3 * MT * DBR;
    LAS bf16_t* Ks = (LAS bf16_t*)lds; LAS bf16_t* Vt = (LAS bf16_t*)(lds + 64 * 264 * 2);
    const int tb = unit & 31, head = (unit >> 5) & 3, b = unit >> 7;
    const int tid = opaque_tid(), wid = tid >> 6, lane = tid & 63, c = lane & 15, i = lane >> 4;
    const size_t tok = (size_t)b * SEQ + tb * 128 + wid * 16 + c;
    bf16x8 qf[8];
#pragma unroll
    for (int ks = 0; ks < 8; ++ks) qf[ks] = load_q_scaled(H + tok * LDH + C_QM + head * 256 + ks * 32 + 8 * i, 0.0625f);
    f32x4 o[16];
#pragma unroll
    for (int dt = 0; dt < 16; ++dt) o[dt] = (f32x4){0.f, 0.f, 0.f, 0.f};
    float m = NEGBIG, lsum = 0.f, alpha; bf16x8 pf, pf1;
    const bf16_t* kb = MKV + (size_t)b * 256 * DM + head * 256; const bf16_t* vb = kb + 1024;
    for (int kt = 0; kt < 4; ++kt) {
        __syncthreads();
        { u32x4 kr[4], vr[4];
#pragma unroll
            for (int it = 0; it < 4; ++it) { const int idx = tid + it * 512, key = idx & 63, seg = idx >> 6; const size_t off = (size_t)(kt * 64 + key) * DM + seg * 8; kr[it] = *(const u32x4*)(kb + off); vr[it] = *(const u32x4*)(vb + off); }
#pragma unroll
            for (int it = 0; it < 4; ++it) { const int idx = tid + it * 512, key = idx & 63, seg = idx >> 6; *(LAS u32x4*)(Ks + key * 264 + seg * 8) = kr[it];
                LAS bf16_t* d = Vt + (seg * 8) * 72 + key; const u32x4 v = vr[it];
                d[0 * 72] = (bf16_t)(v.x & 0xffffu); d[1 * 72] = (bf16_t)(v.x >> 16); d[2 * 72] = (bf16_t)(v.y & 0xffffu); d[3 * 72] = (bf16_t)(v.y >> 16);
                d[4 * 72] = (bf16_t)(v.z & 0xffffu); d[5 * 72] = (bf16_t)(v.z >> 16); d[6 * 72] = (bf16_t)(v.w & 0xffffu); d[7 * 72] = (bf16_t)(v.w >> 16); } }
        __syncthreads();
        attn_step<256>(qf, Ks, Vt, o, m, lsum, alpha, pf, pf1, lane, [](int, float s) { return s * LOG2E; });
    }
    const float inv = 1.0f / fmaxf(lsum, 1e-30f);
#pragma unroll
    for (int dt = 0; dt < 16; ++dt) { const int d0 = 16 * dt + 4 * i; const u32x2 g = *(const u32x2*)(H + tok * LDH + C_GM + head * 256 + d0);
        u32x2 w; w.x = cvt_pk_bf16(o[dt][0] * inv * bflo(g.x), o[dt][1] * inv * bfhi(g.x)); w.y = cvt_pk_bf16(o[dt][2] * inv * bflo(g.y), o[dt][3] * inv * bfhi(g.y));
        *(u32x2*)(O + tok * DBR + head * 256 + d0) = w; }
}

constexpr int NSA_LUT = 0  , NSA_KV = 16384  , NSA_IMP = NSA_KV + 36864  , NSA_SEL = NSA_IMP + 65536;
struct TileRegs { u32x4 k, v; };
__device__ __forceinline__ void tile_issue(TileRegs& r, const int tid, const bf16_t* ksrc, const bf16_t* vsrc, size_t ld, int p0, int pmax) {
    const int kkey = tid >> 3, kseg = tid & 7, pk = p0 + kkey; const int vkey = tid & 63, vseg = tid >> 6, pv = p0 + vkey;
    r.k = (u32x4){0u, 0u, 0u, 0u}; r.v = (u32x4){0u, 0u, 0u, 0u};
    if (pk >= 0 && pk <= pmax) r.k = *(const u32x4*)(ksrc + (size_t)pk * ld + kseg * 8);
    if (pv >= 0 && pv <= pmax) r.v = *(const u32x4*)(vsrc + (size_t)pv * ld + vseg * 8); }
__device__ __forceinline__ void tile_commit(const TileRegs& r, const int tid, LAS bf16_t* Ks, LAS bf16_t* Vt) {
    { const int key = tid >> 3, seg = tid & 7; *(LAS u32x4*)(Ks + key * 72 + seg * 8) = r.k; }
    const int key = tid & 63, seg = tid >> 6;
    LAS bf16_t* d = Vt + (seg * 8) * 72 + key; const u32x4 v = r.v;
    d[0 * 72] = (bf16_t)(v.x & 0xffffu); d[1 * 72] = (bf16_t)(v.x >> 16); d[2 * 72] = (bf16_t)(v.y & 0xffffu); d[3 * 72] = (bf16_t)(v.y >> 16);
    d[4 * 72] = (bf16_t)(v.z & 0xffffu); d[5 * 72] = (bf16_t)(v.z >> 16); d[6 * 72] = (bf16_t)(v.w & 0xffffu); d[7 * 72] = (bf16_t)(v.w >> 16); }
__device__ __forceinline__ void nsa_unit(LAS unsigned char* lds, const Ctx& P, int l, int b, int hkv, int tb) {
    const bf16_t* H = (const bf16_t*)(P.ws + WS_H); bf16_t* O = (bf16_t*)(P.ws + WS_O) + (size_t)2 * MT * DBR;
    const bf16_t* KC = (const bf16_t*)(P.ws + WS_KCV) + (size_t)((b * 4 + hkv) * 256) * 64; const bf16_t* VC = KC + (size_t)4096 * 64;
    LAS bf16_t* KV = (LAS bf16_t*)(lds + NSA_KV);
    LAS float* impb = (LAS float*)(lds + NSA_IMP); LAS unsigned long long* sels = (LAS unsigned long long*)(lds + NSA_SEL);
    const int tid = opaque_tid(), wid = tid >> 6, lane = tid & 63, c = lane & 15, i = lane >> 4, g = wid & 3, th = wid >> 2, hq = hkv * 4 + g;
    const LAS float* lut = (const LAS float*)(lds + NSA_LUT) + g * 1024;
    const int t0 = tb * 64, qb = tb;
    int tq[2]; size_t tok[2];
#pragma unroll
    for (int sb = 0; sb < 2; ++sb) { tq[sb] = t0 + 32 * th + 16 * sb + c; tok[sb] = (size_t)b * SEQ + tq[sb]; }
    bf16x8 qf[2][2];
#pragma unroll
    for (int sb = 0; sb < 2; ++sb)
#pragma unroll
        for (int ks = 0; ks < 2; ++ks) qf[sb][ks] = load_q_scaled(H + tok[sb] * LDH + C_Q + hq * 64 + ks * 32 + 8 * i, 0.125f);
    f32x4* park = (f32x4*)(P.ws + WS_PARK) + ((size_t)(blockIdx.x * 8 + wid) * 8) * 64 + lane;
    float alpha; bf16x8 pf, pf1;
    auto load2 = [&](const bf16_t* ksrc, const bf16_t* vsrc, size_t ld, int p0a, int p0b, bool hasb, int pmax) {
        TileRegs ra, rb; tile_issue(ra, tid, ksrc, vsrc, ld, p0a, pmax); if (hasb) tile_issue(rb, tid, ksrc, vsrc, ld, p0b, pmax);
        tile_commit(ra, tid, KV, KV + 4608); if (hasb) tile_commit(rb, tid, KV + 9216, KV + 9216 + 4608); };
#pragma unroll 1
    for (int sb = 0; sb < 2; ++sb) {
        f32x4 o[4], oi[4]; float m = NEGBIG, lsum = 0.f;
#pragma unroll
        for (int dt = 0; dt < 4; ++dt) { o[dt] = (f32x4){0.f, 0.f, 0.f, 0.f}; oi[dt] = (f32x4){0.f, 0.f, 0.f, 0.f}; }
        bf16x8 ovA[2], ovB[2];
#pragma unroll
        for (int st = 0; st < 2; ++st)
#pragma unroll
            for (int j = 0; j < 8; ++j) { const int nl = 32 * st + (j < 4 ? 4 * i + j : 16 + 4 * i + (j - 4));
                float a = 0.f; if ((nl >> 2) == c) a = ((nl & 3) == 3) ? 0.5f : 1.0f; else if ((nl >> 2) == c - 1 && (nl & 3) == 3) a = 0.5f;
                const float bb = (c == 0 && nl == 63) ? 0.5f : 0.f;
                ovA[st][j] = (short)(__float_as_uint(a) >> 16); ovB[st][j] = (short)(__float_as_uint(bb) >> 16); }
        const int ntile = ((t0 >> 4) + 2) / 64 + 1;
        const int tqs = t0 + 32 * th + 16 * sb + c;
        bf16x8 qs[2];
#pragma unroll
        for (int ks = 0; ks < 2; ++ks) qs[ks] = load_q_scaled(H + ((size_t)b * SEQ + tqs) * LDH + C_Q + hq * 64 + ks * 32 + 8 * i, 0.125f);
#pragma unroll
        for (int pr = 0; pr < 2; ++pr) if (2 * pr < ntile) {
            const bool hasb = 2 * pr + 1 < ntile;
            __syncthreads();
            load2(KC, VC, 64, 128 * pr, 128 * pr + 64, hasb, 255);
            __syncthreads();
#pragma unroll
            for (int sl = 0; sl < 2; ++sl) if (sl == 0 || hasb) {
                const int kt = 2 * pr + sl; const LAS bf16_t* Ks = KV + sl * 9216; const LAS bf16_t* Vt = Ks + 4608; const int nb = kt * 64;
                attn_step<64>(qs, Ks, Vt, o, m, lsum, alpha, pf, pf1, lane,
                    [&](int kk, float s) { const int dist = tqs - (16 * (nb + kk) + 31); return dist >= 0 ? s * LOG2E + lut[min((unsigned)dist, 1023u)] : NEGBIG; });
#pragma unroll
                for (int jt = 0; jt < 4; ++jt) oi[jt] *= alpha;
                oi[kt] = mfma16(ovA[0], pf, oi[kt]); oi[kt] = mfma16(ovA[1], pf1, oi[kt]);
                if (kt + 1 < 4) { oi[kt + 1 < 4 ? kt + 1 : 3] = mfma16(ovB[0], pf, oi[kt + 1 < 4 ? kt + 1 : 3]); oi[kt + 1 < 4 ? kt + 1 : 3] = mfma16(ovB[1], pf1, oi[kt + 1 < 4 ? kt + 1 : 3]); }
            }
        }
        const float inv = 1.0f / fmaxf(lsum, 1e-30f);
        const float g0 = sigmoidf_(bf2f(H[((size_t)b * SEQ + tqs) * LDH + C_GL + hq]) + P.in[21][l * 48 + hq]) * inv;
#pragma unroll
        for (int dt = 0; dt < 4; ++dt) { park[(sb * 4 + dt) * 64] = o[dt] * g0;
            *(LAS f32x4*)(impb + (g * 64 + 32 * th + 16 * sb + c) * 64 + 16 * dt + 4 * i) = oi[dt] * inv; }
    }
    __syncthreads();
    {
#pragma unroll
        for (int tt = 0; tt < 8; ++tt) { const int tl = 8 * wid + tt;
            unsigned long long mask;
            if (qb <= 7) mask = (2ull << qb) - 1ull;
            else {
                const float v = impb[(0 * 64 + tl) * 64 + lane] + impb[(1 * 64 + tl) * 64 + lane] + impb[(2 * 64 + tl) * 64 + lane] + impb[(3 * 64 + tl) * 64 + lane];
                float vv = (lane >= 1 && lane <= qb - 2) ? v : -__builtin_inff();
                mask = 1ull | (1ull << qb) | (1ull << (qb - 1));
#pragma unroll
                for (int r = 0; r < 5; ++r) { const float mx = wave_max(vv); const unsigned long long bal = __ballot(vv == mx);
                    const int js = __builtin_ctzll(bal); mask |= 1ull << js; if (lane == js) vv = -__builtin_inff(); }
            }
            if (lane == 0) sels[tl] = mask; }
    }
    __syncthreads();
    {
        unsigned long long ms[2]; unsigned long long U = 0ull;
#pragma unroll
        for (int sb = 0; sb < 2; ++sb) ms[sb] = sels[32 * th + 16 * sb + c];
        for (int t = 0; t < 64; ++t) U |= sels[t];
        f32x4 o[2][4]; float m[2], lsum[2];
#pragma unroll
        for (int sb = 0; sb < 2; ++sb) { m[sb] = NEGBIG; lsum[sb] = 0.f;
#pragma unroll
            for (int dt = 0; dt < 4; ++dt) o[sb][dt] = (f32x4){0.f, 0.f, 0.f, 0.f}; }
        const bf16_t* kb = H + (size_t)b * SEQ * LDH + C_KS + hkv * 64; const bf16_t* vb = H + (size_t)b * SEQ * LDH + C_VS + hkv * 64;
        U &= ((2ull << qb) - 1ull);
        unsigned long long Ur = ((unsigned long long)(unsigned)__builtin_amdgcn_readfirstlane((int)(U >> 32)) << 32) | (unsigned)__builtin_amdgcn_readfirstlane((int)U);
        const float cfar = lut[790];
        while (Ur != 0ull) {
            const int ja = __builtin_ctzll(Ur); Ur &= Ur - 1ull; const bool hasb = Ur != 0ull; int jb = 0; if (hasb) { jb = __builtin_ctzll(Ur); Ur &= Ur - 1ull; }
            __syncthreads();
            load2(kb, vb, LDH, ja * 64, jb * 64, hasb, SEQ - 1);
            __syncthreads();
#pragma unroll
            for (int sl = 0; sl < 2; ++sl) if (sl == 0 || hasb) {
                const int j = sl ? jb : ja; const LAS bf16_t* Ks = KV + sl * 9216; const LAS bf16_t* Vt = Ks + 4608;
                const bool far = t0 - (64 * j + 63) >= 790;
#pragma unroll
                for (int sb = 0; sb < 2; ++sb) { const bool selj = (ms[sb] >> j) & 1ull; const int tqs = tq[sb];
                    if (far) {
                        if (__builtin_amdgcn_ballot_w64(selj) == 0ull) continue;
                        attn_step<64>(qf[sb], Ks, Vt, o[sb], m[sb], lsum[sb], alpha, pf, pf1, lane,
                            [&](int, float s) { return selj ? s * LOG2E + cfar : NEGBIG; });
                    } else { const int kp0 = j * 64;
                        attn_step<64>(qf[sb], Ks, Vt, o[sb], m[sb], lsum[sb], alpha, pf, pf1, lane,
                            [&](int kk, float s) { const int dist = tqs - (kp0 + kk); return (selj && dist >= 0) ? s * LOG2E + lut[min((unsigned)dist, 1023u)] : NEGBIG; });
                    }
                }
            }
        }
#pragma unroll
        for (int sb = 0; sb < 2; ++sb) { const float g1 = sigmoidf_(bf2f(H[tok[sb] * LDH + C_GL + 16 + hq]) + P.in[21][l * 48 + 16 + hq]) / fmaxf(lsum[sb], 1e-30f);
#pragma unroll
            for (int dt = 0; dt < 4; ++dt) park[(sb * 4 + dt) * 64] += o[sb][dt] * g1; }
    }
    {
        f32x4 o[2][4]; float m[2], lsum[2];
#pragma unroll
        for (int sb = 0; sb < 2; ++sb) { m[sb] = NEGBIG; lsum[sb] = 0.f;
#pragma unroll
            for (int dt = 0; dt < 4; ++dt) o[sb][dt] = (f32x4){0.f, 0.f, 0.f, 0.f}; }
        const bf16_t* kb = H + (size_t)b * SEQ * LDH + C_KW + hkv * 64; const bf16_t* vb = H + (size_t)b * SEQ * LDH + C_VW + hkv * 64;
        const int kfirst = (t0 >= 256) ? 0 : (256 - t0) / 64;
        for (int k = kfirst; k < 5; k += 2) { const int p0 = t0 - 256 + 64 * k; const bool hasb = k + 1 < 5;
            __syncthreads();
            load2(kb, vb, LDH, p0, p0 + 64, hasb, SEQ - 1);
            __syncthreads();
#pragma unroll
            for (int sl = 0; sl < 2; ++sl) if (sl == 0 || hasb) { const LAS bf16_t* Ks = KV + sl * 9216; const LAS bf16_t* Vt = Ks + 4608; const int kp0 = p0 + sl * 64;
#pragma unroll
                for (int sb = 0; sb < 2; ++sb) { const int tqs = tq[sb];
                    attn_step<64>(qf[sb], Ks, Vt, o[sb], m[sb], lsum[sb], alpha, pf, pf1, lane,
                        [&](int kk, float s) { const int kpos = kp0 + kk, dist = tqs - kpos; return (dist >= 0 && dist < 256 && kpos >= 0) ? s * LOG2E + lut[min((unsigned)dist, 1023u)] : NEGBIG; }); }
            }
        }
#pragma unroll
        for (int sb = 0; sb < 2; ++sb) { const float g2 = sigmoidf_(bf2f(H[tok[sb] * LDH + C_GL + 32 + hq]) + P.in[21][l * 48 + 32 + hq]) / fmaxf(lsum[sb], 1e-30f);
#pragma unroll
            for (int dt = 0; dt < 4; ++dt) { const f32x4 r = park[(sb * 4 + dt) * 64] + o[sb][dt] * g2;
                const int d0 = 16 * dt + 4 * i; const u32x2 gg = *(const u32x2*)(H + tok[sb] * LDH + C_GC + hq * 64 + d0);
                u32x2 w; w.x = cvt_pk_bf16(r[0] * bflo(gg.x), r[1] * bfhi(gg.x)); w.y = cvt_pk_bf16(r[2] * bflo(gg.y), r[3] * bfhi(gg.y));
                *(u32x2*)(O + tok[sb] * DBR + hq * 64 + d0) = w; } }
    }
}

__device__ __forceinline__ void gmlp_unit(LAS unsigned char* lds, const Ctx& P, int l, int unit) {
    const bf16_t* H = (const bf16_t*)(P.ws + WS_H); const bf16_t* SGW = (const bf16_t*)(P.ws + WS_SGW); bf16_t* O = (bf16_t*)(P.ws + WS_O);
    const float* lng = P.in[4] + l * DBR; const float* lnb = P.in[5] + l * DBR; const float* sgb = P.in[7] + l * 8 * 128;
    LAS float* stats = (LAS float*)lds; LAS bf16_t* vT = (LAS bf16_t*)(lds + 1024);
    const int hf = unit & 1, bc = unit >> 1; const size_t tok0 = (size_t)bc * 128;
    const int tid = opaque_tid(), wid = tid >> 6, lane = tid & 63, c = lane & 15, i = lane >> 4;
    __syncthreads();
#pragma unroll 2
    for (int r = 0; r < 16; ++r) { const int t = wid * 16 + r; const bf16_t* row = H + (tok0 + t) * LDH + C_V;
        const u32x4 a = *(const u32x4*)(row + lane * 8), bb = *(const u32x4*)(row + 512 + lane * 8);
        const float x[16] = {bflo(a.x), bfhi(a.x), bflo(a.y), bfhi(a.y), bflo(a.z), bfhi(a.z), bflo(a.w), bfhi(a.w), bflo(bb.x), bfhi(bb.x), bflo(bb.y), bfhi(bb.y), bflo(bb.z), bfhi(bb.z), bflo(bb.w), bfhi(bb.w)};
        float s = 0.f;
#pragma unroll
        for (int e = 0; e < 16; ++e) s += x[e];
        const float mean = wave_sum(s) * (1.0f / 1024.0f); float q = 0.f;
#pragma unroll
        for (int e = 0; e < 16; ++e) q += (x[e] - mean) * (x[e] - mean);
        const float var = wave_sum(q) * (1.0f / 1024.0f);
        if (lane == 0) { stats[2 * t] = mean; stats[2 * t + 1] = rsqrtf(var + 1e-5f); } }
    __syncthreads();
    for (int gi = 0; gi < 4; ++gi) { const int g = hf * 4 + gi;
        { const int s = tid >> 2, dseg = tid & 3; const float mean = stats[2 * s], rstd = stats[2 * s + 1];
            const bf16_t* row = H + (tok0 + s) * LDH + C_V + g * 128 + dseg * 32;
#pragma unroll
            for (int q4 = 0; q4 < 4; ++q4) { const u32x4 w = *(const u32x4*)(row + q4 * 8);
                const float x[8] = {bflo(w.x), bfhi(w.x), bflo(w.y), bfhi(w.y), bflo(w.z), bfhi(w.z), bflo(w.w), bfhi(w.w)};
                const int chb = g * 128 + dseg * 32 + q4 * 8; const f32x4 g0 = *(const f32x4*)(lng + chb), g1 = *(const f32x4*)(lng + chb + 4), b0 = *(const f32x4*)(lnb + chb), b1 = *(const f32x4*)(lnb + chb + 4);
#pragma unroll
                for (int e = 0; e < 8; ++e) { const int d = dseg * 32 + q4 * 8 + e;
                    const float val = (x[e] - mean) * rstd * (e < 4 ? g0[e & 3] : g1[e & 3]) + (e < 4 ? b0[e & 3] : b1[e & 3]); vT[d * 136 + s] = (bf16_t)(cvt_pk_bf16(val, 0.f) & 0xffffu); } } }
        __syncthreads();
        f32x4 acc[8];
#pragma unroll
        for (int nt = 0; nt < 8; ++nt) acc[nt] = (f32x4){0.f, 0.f, 0.f, 0.f};
        const int nks = (16 * wid + 15) / 32 + 1;
        for (int ks = 0; ks < nks; ++ks) { const bf16x8 wf = *(const bf16x8*)(SGW + ((size_t)(g * 128 + 16 * wid + c)) * 128 + ks * 32 + 8 * i);
#pragma unroll
            for (int nt = 0; nt < 8; ++nt) { const bf16x8 vf = *(const LAS bf16x8*)(vT + (16 * nt + c) * 136 + ks * 32 + 8 * i); acc[nt] = mfma16(vf, wf, acc[nt]); } }
        { const int t = 16 * wid + c; const size_t tok = tok0 + t; const float bs = sgb[g * 128 + t];
#pragma unroll
            for (int nt = 0; nt < 8; ++nt) { const int ch0 = g * 128 + 16 * nt + 4 * i;
                const u32x2 uu = *(const u32x2*)(H + tok * LDH + C_U + ch0), gg = *(const u32x2*)(H + tok * LDH + C_GA + ch0);
                u32x2 w; w.x = cvt_pk_bf16((acc[nt][0] + bs) * bflo(uu.x) * bflo(gg.x), (acc[nt][1] + bs) * bfhi(uu.x) * bfhi(gg.x));
                w.y = cvt_pk_bf16((acc[nt][2] + bs) * bflo(uu.y) * bflo(gg.y), (acc[nt][3] + bs) * bfhi(uu.y) * bfhi(gg.y));
                *(u32x2*)(O + tok * DBR + ch0) = w; } }
        __syncthreads();
    }
}

__device__ __forceinline__ void lru_a_unit(LAS unsigned char* lds, const Ctx& P, int l, int unit) {
    const bf16_t* H = (const bf16_t*)(P.ws + WS_H); const bf16_t* WAT = (const bf16_t*)(P.ws + WS_WAT);
    unsigned* LRW = (unsigned*)(P.ws + WS_LRA);
    const float* cw = P.in[8] + l * 4 * DBR; const float* cb = P.in[9] + l * DBR; const float* ba = P.in[11] + l * DBR; const float* bx = P.in[13] + l * DBR; const float* SP8 = (const float*)(P.ws + WS_PEW1) + 512;
    LAS bf16_t* xc = (LAS bf16_t*)lds; const LAS bf16_t* wl = (const LAS bf16_t*)(lds + 34816);
    const int n = unit & 7, bc = unit >> 3, b = bc >> 5, ck = bc & 31;
    const int tid = opaque_tid(), wid = tid >> 6, lane = tid & 63, c = lane & 15, i = lane >> 4;
    __syncthreads();
    { const int t = tid >> 2, dseg = tid & 3, pos = ck * 128 + t;
        u32x4 xr[4][4];
#pragma unroll
        for (int k = 0; k < 4; ++k) { const int pp = pos - 3 + k;
#pragma unroll
            for (int q4 = 0; q4 < 4; ++q4) { xr[k][q4] = (u32x4){0u, 0u, 0u, 0u};
                if (pp >= 0) xr[k][q4] = *(const u32x4*)(H + ((size_t)b * SEQ + pp) * LDH + C_XB + n * 128 + dseg * 32 + q4 * 8); } }
#pragma unroll
        for (int q4 = 0; q4 < 4; ++q4) { const int ch0 = n * 128 + dseg * 32 + q4 * 8; float a8[8];
            { const f32x4 c0 = *(const f32x4*)(cb + ch0), c1 = *(const f32x4*)(cb + ch0 + 4);
#pragma unroll
                for (int e = 0; e < 4; ++e) { a8[e] = c0[e]; a8[4 + e] = c1[e]; } }
#pragma unroll
            for (int k = 0; k < 4; ++k) { const u32x4 w = xr[k][q4];
                const f32x4 w0 = *(const f32x4*)(cw + k * DBR + ch0), w1 = *(const f32x4*)(cw + k * DBR + ch0 + 4);
                const float x[8] = {bflo(w.x), bfhi(w.x), bflo(w.y), bfhi(w.y), bflo(w.z), bfhi(w.z), bflo(w.w), bfhi(w.w)};
#pragma unroll
                for (int e = 0; e < 4; ++e) { a8[e] += w0[e] * x[e]; a8[4 + e] += w1[e] * x[4 + e]; } }
            u32x4 w; w.x = cvt_pk_bf16(a8[0], a8[1]); w.y = cvt_pk_bf16(a8[2], a8[3]); w.z = cvt_pk_bf16(a8[4], a8[5]); w.w = cvt_pk_bf16(a8[6], a8[7]);
            *(LAS u32x4*)(xc + t * 136 + dseg * 32 + q4 * 8) = w; } }
    __syncthreads();
    bf16x8 yf[4];
#pragma unroll
    for (int ks = 0; ks < 4; ++ks) yf[ks] = *(const LAS bf16x8*)(xc + (16 * wid + c) * 136 + ks * 32 + 8 * i);
    const int t = 16 * wid + c; const size_t tok = (size_t)bc * 128 + t;
#pragma unroll
    for (int nt = 0; nt < 8; ++nt) { f32x4 aA = (f32x4){0.f, 0.f, 0.f, 0.f}, aX = (f32x4){0.f, 0.f, 0.f, 0.f};
#pragma unroll
        for (int ks = 0; ks < 4; ++ks) { const bf16x8 wa = *(const LAS bf16x8*)(wl + (16 * nt + c) * 136 + ks * 32 + 8 * i);
            const bf16x8 wx = *(const LAS bf16x8*)(wl + (128 + 16 * nt + c) * 136 + ks * 32 + 8 * i);
            aA = mfma16(wa, yf[ks], aA); aX = mfma16(wx, yf[ks], aX); }
        const int e0 = 16 * nt + 4 * i, ch0 = n * 128 + e0; const u32x2 xw = *(const LAS u32x2*)(xc + t * 136 + e0);
        const float xv[4] = {bflo(xw.x), bfhi(xw.x), bflo(xw.y), bfhi(xw.y)}; f32x4 av, gv;
        const f32x4 bav = *(const f32x4*)(ba + ch0), bxv = *(const f32x4*)(bx + ch0), spv = *(const f32x4*)(SP8 + ch0);
#pragma unroll
        for (int r = 0; r < 4; ++r) { const float rr = sigmoidf_(aA[r] + bav[r]), ii = sigmoidf_(aX[r] + bxv[r]);
            const float a = __expf(-rr * spv[r]);
            av[r] = a; gv[r] = __builtin_amdgcn_sqrtf(fmaxf(1.0f - a * a, 0.f)) * ii * xv[r]; }
        u32x4 pw;
#pragma unroll
        for (int r = 0; r < 4; ++r) { const float am = fmaxf(1.0f - __expf(-spv[r]), 1e-30f);
            const unsigned q = (unsigned)fminf((1.0f - av[r]) * (65535.0f * __builtin_amdgcn_rcpf(am)) + 0.5f, 65535.0f); pw[r] = (cvt_pk_bf16(0.f, gv[r]) & 0xffff0000u) | q; }
        *(u32x4*)(LRW + tok * DBR + ch0) = pw; }
}

__device__ __forceinline__ void fast_sync(unsigned* ctl, unsigned gen, unsigned nwg) {
    __syncthreads();
    if (threadIdx.x == 0) {
        __builtin_amdgcn_fence(__ATOMIC_RELEASE, "agent");
        asm volatile("s_waitcnt vmcnt(0) lgkmcnt(0)" ::: "memory");
        bool last = false;
        if (__hip_atomic_fetch_add(ctl + 256 + 32 * (blockIdx.x & 7), 1u, __ATOMIC_RELAXED, __HIP_MEMORY_SCOPE_AGENT) == gen * (nwg >> 3) - 1u) {
            if (__hip_atomic_fetch_add(ctl, 1u, __ATOMIC_RELAXED, __HIP_MEMORY_SCOPE_AGENT) == gen * 8u - 1u) { __hip_atomic_store(ctl + 32, gen, __ATOMIC_RELAXED, __HIP_MEMORY_SCOPE_AGENT); last = true; } }
        if (!last) while (__hip_atomic_load(ctl + 32, __ATOMIC_RELAXED, __HIP_MEMORY_SCOPE_AGENT) < gen) __builtin_amdgcn_s_sleep(1);
        __builtin_amdgcn_fence(__ATOMIC_ACQUIRE, "agent");
        asm volatile("s_waitcnt vmcnt(0) lgkmcnt(0)" ::: "memory");
    }
    __syncthreads();
}

__global__ void __launch_bounds__(512, 2) fwd_megakernel(Params PK) {
    extern __shared__ __attribute__((aligned(16))) unsigned char lds_raw[];
    LAS unsigned char* lds = (LAS unsigned char*)lds_raw;
    cg::grid_group grid = cg::this_grid();
    LAS u64_t* pl = (LAS u64_t*)(lds + PL_OFF);
    if (threadIdx.x == 0) {
#pragma unroll
        for (int k = 0; k < 27; ++k) pl[k] = (u64_t)PK.in[k];
        pl[27] = (u64_t)PK.out; pl[28] = (u64_t)PK.ws; }
    __syncthreads();
    const int G = gridDim.x, bid = blockIdx.x;
    const size_t gstride = (size_t)G * 512;
    const int ph_lo = PK.ph_lo, ph_hi = PK.ph_hi;
    unsigned nbar = 0u;

    for (int gp = ph_lo; gp < ph_hi; ++gp) {
        const int tid = opaque_tid(); const size_t gtid = (size_t)bid * 512 + tid;
        asm volatile("" ::: "memory");
        Ctx P; P.in.pl = pl; P.out = (float*)P.in[27]; P.ws = (unsigned char*)P.in[28];
        unsigned char* ws = P.ws; bf16_t* Hh = (bf16_t*)(ws + WS_H);
        const int l = gp >= 9 ? 1 : 0; const int ph = gp == 0 ? 0 : (gp <= 8 ? gp : (gp == 16 ? 8 : gp - 8));
        if (gp == 0) prologue(lds, P, 0);
        else if (ph == 1) {
            { pg8::SchedStd S{64, 75, G, bid, DM, (const bf16_t*)(ws + (l == 0 ? WS_XB : WS_XB2)), (const bf16_t*)(ws + WS_WIN)}; pg8::EpiInProj E{Hh, ws + WS_G8}; pg8::gemm_phase(lds, DM, S, E); }
            { pg8::SchedStd S{4, 8, G, G - 1 - bid, DM, (const bf16_t*)(ws + WS_MEMB), (const bf16_t*)(ws + WS_WMEM)}; pg8::EpiBf16 E{(bf16_t*)(ws + WS_MKV), DM, 0, nullptr, 0, 0}; pg8::gemm_phase(lds, DM, S, E); }
        } else if (ph == 2) {
            for (int u = bid; u < 256; u += G) gmlp_unit(lds, P, l, u);
            { int cur_n = -1;
                for (int u = bid; u < 1024; u += G) { const int n = u & 7;
                    if (n != cur_n) { __syncthreads(); const bf16_t* WAT = (const bf16_t*)(ws + WS_WAT); LAS bf16_t* wl = (LAS bf16_t*)(lds + 34816);
                        for (int q = tid; q < 2 * 128 * 16; q += 512) { const int mat = q >> 11, r = (q >> 4) & 127, sg = q & 15;
                            *(LAS u32x4*)(wl + (mat * 128 + r) * 136 + sg * 8) = *(const u32x4*)(WAT + ((size_t)(mat * 8 + n) * 128 + r) * 128 + sg * 8); }
                        cur_n = n; __syncthreads(); }
                    lru_a_unit(lds, P, l, u); } }
            { bf16_t* A0 = (bf16_t*)(ws + WS_A0);
                for (size_t idx = gtid; idx < (size_t)2 * 4096 * 256; idx += gstride) { const int ch = (int)(idx & 255), row = (int)((idx >> 8) & 4095), kv = (int)(idx >> 20);
                    const int j = ch >> 3, d8 = (ch & 7) * 8, bh = row >> 8, n = row & 255, b = bh >> 2, hkv = bh & 3;
                    u32x4 v = (u32x4){0u, 0u, 0u, 0u};
                    if (n < 255) v = *(const u32x4*)(Hh + ((size_t)b * SEQ + 16 * n + j) * LDH + (kv ? C_VC : C_KC) + hkv * 64 + d8);
                    *(u32x4*)(A0 + ((size_t)kv * 4096 + row) * 2048 + j * 64 + d8) = v; } }
            __syncthreads();
            for (int u = bid; u < 512; u += G) memattn_unit(lds, P, u);
        } else if (ph == 3) {
            { const unsigned* LRW = (const unsigned*)(ws + WS_LRA); float* AGP = (float*)(ws + WS_AGG); float* AGH = AGP + 128 * 1024;
                for (size_t id = gtid; id < (size_t)128 * 1024; id += gstride) { const int ch = (int)(id & 1023), bc = (int)(id >> 10); const size_t base = (size_t)bc * 128 * DBR + ch;
                    float p = 1.f, h = 0.f; const float sc = fmaxf(1.0f - __expf(-((const float*)(ws + WS_PEW1))[512 + ch]), 1e-30f) * (1.0f / 65535.0f);
#pragma unroll 8
                    for (int t = 0; t < 128; ++t) { const unsigned w = LRW[base + (size_t)t * DBR]; const float a = 1.0f - (float)(w & 0xffffu) * sc, g = bfhi(w); p *= a; h = a * h + g; }
                    AGP[id] = p; AGH[id] = h; } }
            { pg8::SchedCmp1 S{bid, (const bf16_t*)(ws + WS_A0), (const bf16_t*)(ws + WS_W1T)}; pg8::EpiBf16 E{(bf16_t*)(ws + WS_HID), 256, (size_t)4096 * 256, (const float*)(ws + WS_PEW1), 256, 2}; pg8::gemm_phase(lds, 2048, S, E); }
        } else if (ph == 4) {
            { const unsigned* LRW = (const unsigned*)(ws + WS_LRA); const float* AGP = (const float*)(ws + WS_AGG); const float* AGH = AGP + 128 * 1024;
                bf16_t* Ob = (bf16_t*)(ws + WS_O) + (size_t)1 * MT * DBR;
                for (size_t id = gtid; id < (size_t)128 * 1024; id += gstride) { const int ch = (int)(id & 1023), bc = (int)(id >> 10), b = bc >> 5, ck = bc & 31; const size_t base = (size_t)bc * 128 * DBR + ch;
                    float h = 0.f; const float sc = fmaxf(1.0f - __expf(-((const float*)(ws + WS_PEW1))[512 + ch]), 1e-30f) * (1.0f / 65535.0f);
                    for (int j = 0; j < ck; ++j) { const size_t a = (size_t)(b * 32 + j) * 1024 + ch; h = AGP[a] * h + AGH[a]; }
#pragma unroll 8
                    for (int t = 0; t < 128; ++t) { const unsigned w = LRW[base + (size_t)t * DBR]; const float a = 1.0f - (float)(w & 0xffffu) * sc, g = bfhi(w); h = a * h + g;
                        const float sg = bf2f(Hh[((size_t)bc * 128 + t) * LDH + C_GB + ch]);
                        Ob[base + (size_t)t * DBR] = (bf16_t)(cvt_pk_bf16(h * sg, 0.f) & 0xffffu); } } }
            { const bf16_t* HID = (const bf16_t*)(ws + WS_HID); bf16_t* KCV = (bf16_t*)(ws + WS_KCV);
                for (size_t id = gtid; id < (size_t)2 * 4096 * 16; id += gstride) { const int e4 = (int)(id & 15) * 4, row = (int)((id >> 4) & 4095), kv = (int)(id >> 16);
                    const float* w2 = P.in[19 + kv] + (size_t)l * 256 * 64; const bf16_t* hr = HID + ((size_t)kv * 4096 + row) * 256; f32x4 a = (f32x4){0.f, 0.f, 0.f, 0.f};
#pragma unroll 8
                    for (int k = 0; k < 256; k += 2) { const unsigned hw = *(const unsigned*)(hr + k);
                        a += *(const f32x4*)(w2 + (size_t)k * 64 + e4) * bflo(hw); a += *(const f32x4*)(w2 + (size_t)(k + 1) * 64 + e4) * bfhi(hw); }
                    u32x2 w; w.x = cvt_pk_bf16(a[0], a[1]); w.y = cvt_pk_bf16(a[2], a[3]); *(u32x2*)(KCV + ((size_t)kv * 4096 + row) * 64 + e4) = w; } }
        } else if (ph == 5) {
            int cur_hkv = -1;
            for (int u = bid; u < 1024; u += G) { const int v = u & 255, k = u >> 8, x = v >> 4, b = (v >> 2) & 3, hkv = v & 3, tb = (k & 1) ? 16 * k + 15 - x : 16 * k + x;
                if (hkv != cur_hkv) { __syncthreads(); const float* src = (const float*)(ws + WS_LUT) + (size_t)hkv * 4 * 4096; LAS float* dst = (LAS float*)(lds + NSA_LUT);
                    for (int q = tid; q < 4096; q += 512) dst[q] = src[(q >> 10) * 4096 + (q & 1023)];
                    cur_hkv = hkv; __syncthreads(); }
                nsa_unit(lds, P, l, b, hkv, tb); }
        } else if (ph == 6) {
            pg8::SchedMerge S{G, bid, (const bf16_t*)(ws + WS_O), (const bf16_t*)(ws + WS_WBR)}; pg8::EpiMerge E{(bf16_t*)(ws + WS_XB), ws + WS_G8}; pg8::gemm_phase(lds, DBR, S, E);
        } else if (ph == 7) {
            pg8::SchedOut S{bid, (const bf16_t*)(ws + WS_XB), (const bf16_t*)(ws + WS_WOUT)};
            pg8::EpiOutLN E{l == 0 ? P.in[0] : (const float*)P.out, P.out, l == 0 ? (bf16_t*)(ws + WS_XB2) : (bf16_t*)nullptr, P.in[25] + l * DM, P.in[26] + l * DM,
                            (unsigned*)ws + 64 + l * 64, (unsigned long long*)(ws + WS_LNX), lds + 131072};
            pg8::gemm_phase(lds, DM, S, E);
        } else if (ph == 8) {
            if (l == 0) prologue(lds, P, 1);
        }
        if (gp + 1 < ph_hi) { if (gp == ph_lo) grid.sync(); else { ++nbar; fast_sync((unsigned*)ws, nbar, (unsigned)G); } }
    }
}

extern "C" void kernel_launch(void* const* d_in, const int* in_sizes, int n_in, void* d_out, int out_size, void* d_ws, size_t ws_size, hipStream_t stream) {
    static int grid_blocks = 0;
    if (grid_blocks == 0) {
        if (n_in != 27 || ws_size < WS_END) { fprintf(stderr, "kernel_launch: unexpected n_in %d or ws_size %zu (< %zu)\n", n_in, ws_size, (size_t)WS_END); grid_blocks = -1; return; }
        int dev = 0, cus = 0, per_cu = 0;
        hipGetDevice(&dev); hipDeviceGetAttribute(&cus, hipDeviceAttributeMultiprocessorCount, dev);
        if (hipFuncSetAttribute((const void*)fwd_megakernel, hipFuncAttributeMaxDynamicSharedMemorySize, LDS_BYTES) != hipSuccess) { fprintf(stderr, "kernel_launch: hipFuncSetAttribute failed\n"); grid_blocks = -1; return; }
        hipOccupancyMaxActiveBlocksPerMultiprocessor(&per_cu, (const void*)fwd_megakernel, 512, LDS_BYTES);
        (void)hipGetLastError();
        if (per_cu < 1) per_cu = 1;
        if (cus < 256) { fprintf(stderr, "kernel_launch: built for a 256-CU device (got %d CUs); nothing launched\n", cus); grid_blocks = -1; return; }
        grid_blocks = 256;
        fprintf(stderr, "kernel_launch: cus %d per_cu %d grid %d\n", cus, per_cu, grid_blocks);
    }
    if (grid_blocks < 0) return;
    if (hipMemsetAsync(d_ws, 0, 4096, stream) != hipSuccess) { fprintf(stderr, "kernel_launch: hipMemsetAsync failed\n"); return; }
    Params p{};
    for (int i = 0; i < 27; ++i) p.in[i] = (const float*)d_in[i];
    p.out = (float*)d_out; p.ws = (unsigned char*)d_ws; p.ph_lo = 0; p.ph_hi = 16;
    void* args[] = {&p};
    hipError_t e = hipLaunchCooperativeKernel((const void*)fwd_megakernel, dim3(grid_blocks), dim3(512), args, LDS_BYTES, stream);
    if (e != hipSuccess) fprintf(stderr, "cooperative launch failed: %s (grid %d)\n", hipGetErrorString(e), grid_blocks);
}
```
